# Optimizing an MI355X kernel written in HIP

```python
import jax, jax.numpy as jnp
from jax import lax
import numpy as np

D_MODEL = 1024
BATCH = 4
SEQ = 8192
DEPTH = 4

GRID_W = 64
CTX_LEN = 256
N_EVEN = (DEPTH + 1) // 2
N_ODD = DEPTH // 2
N_SUB = 3
N_MOD = 3 * N_SUB
D_FF = ((8 * D_MODEL // 3) + 255) // 256 * 256
FFN_RES = 0.5
LRU_WIDTH = D_MODEL // 2
LRU_BW = 64
LRU_BLOCKS = LRU_WIDTH // LRU_BW
LRU_C = 8.0
CONV_W = 4
WIN_HD = 64
WIN_HEADS = (D_MODEL // 2) // WIN_HD
WIN_KV = WIN_HEADS // 4
WIN_G = WIN_HEADS // WIN_KV
WINDOW = 128
GLB_HD = 128
GLB_HEADS = D_MODEL // GLB_HD
GLB_KV = GLB_HEADS // 4
GLB_G = GLB_HEADS // GLB_KV
Q_BLOCK = 128
ROPE_THETA = 10000.0
EPS = 1e-6
EVEN_SPLITS = (LRU_WIDTH, LRU_WIDTH, WIN_HEADS * WIN_HD, WIN_KV * WIN_HD, WIN_KV * WIN_HD)
ODD_SPLITS = (GLB_HEADS * GLB_HD, GLB_KV * GLB_HD, GLB_KV * GLB_HD)
EVEN_IN = sum(EVEN_SPLITS)
ODD_IN = sum(ODD_SPLITS)
EVEN_OUT = LRU_WIDTH + WIN_HEADS * WIN_HD
ODD_OUT = GLB_HEADS * GLB_HD

kernel_name = 'hybrid_dit_rglru_window_axial_block'


def _rmsnorm(x, g):
    xf = x.astype(jnp.float32)
    y = xf * lax.rsqrt(jnp.mean(xf * xf, axis=-1, keepdims=True) + EPS)
    return (y * g.astype(jnp.float32)).astype(x.dtype)


def _modulate(h, shift, scale):
    return h * (1 + scale) + shift


def _split(p, sizes):
    out, o = [], 0
    for s in sizes:
        out.append(p[..., o:o + s])
        o += s
    return out


def _axial_rope(row, col, hd):
    n_freq = hd // 4
    freq = ROPE_THETA ** (-jnp.arange(n_freq, dtype=jnp.float32) / n_freq)
    ang = jnp.concatenate([row.astype(jnp.float32)[:, None] * freq,
                           col.astype(jnp.float32)[:, None] * freq], axis=-1)
    return jnp.cos(ang), jnp.sin(ang)


def _apply_rope(x, rope):
    cos, sin = rope
    hd = x.shape[-1]
    xf = x.astype(jnp.float32).reshape(x.shape[:-1] + (hd // 2, 2))
    shape = (x.shape[1],) + (1,) * (x.ndim - 3) + (hd // 2,)
    cos = cos.reshape(shape)
    sin = sin.reshape(shape)
    x1, x2 = xf[..., 0], xf[..., 1]
    out = jnp.stack([x1 * cos - x2 * sin, x1 * sin + x2 * cos], axis=-1).reshape(x.shape)
    return out.astype(x.dtype)


def _gqa_attend(q, k, v, mask, sink):
    scale = q.shape[-1] ** -0.5
    s = jnp.einsum('bqkgd,bskd->bkgqs', q, k).astype(jnp.float32) * scale
    if mask is not None:
        s = jnp.where(mask, s, -jnp.inf)
    if sink is not None:
        snk = jnp.broadcast_to(sink.astype(jnp.float32)[None, :, :, None, None], s.shape[:-1] + (1,))
        p = jax.nn.softmax(jnp.concatenate([s, snk], axis=-1), axis=-1)[..., :-1]
    else:
        p = jax.nn.softmax(s, axis=-1)
    return jnp.einsum('bkgqs,bskd->bqkgd', p.astype(v.dtype), v)


def _window_attention(q, k, v, kc, vc, sink):
    B_, T = q.shape[0], q.shape[1]
    nb = T // Q_BLOCK
    band = Q_BLOCK + 2 * WINDOW
    pad = ((0, 0), (WINDOW, WINDOW), (0, 0), (0, 0))
    kp = jnp.pad(k, pad)
    vp = jnp.pad(v, pad)
    qb = q.reshape((B_, nb, Q_BLOCK) + q.shape[2:]).swapaxes(0, 1)
    ctx_valid = jnp.ones((Q_BLOCK, kc.shape[1]), dtype=bool)

    def block(args):
        n, q_blk = args
        start = n * Q_BLOCK
        k_loc = lax.dynamic_slice_in_dim(kp, start, band, axis=1)
        v_loc = lax.dynamic_slice_in_dim(vp, start, band, axis=1)
        qpos = start + jnp.arange(Q_BLOCK)
        kpos = start - WINDOW + jnp.arange(band)
        valid = (jnp.abs(kpos[None, :] - qpos[:, None]) <= WINDOW) & (kpos[None, :] >= 0) & (kpos[None, :] < T)
        mask = jnp.concatenate([valid, ctx_valid], axis=1)
        return _gqa_attend(q_blk, jnp.concatenate([k_loc, kc], axis=1),
                           jnp.concatenate([v_loc, vc], axis=1), mask, sink)

    out = lax.map(block, (jnp.arange(nb), qb))
    return out.swapaxes(0, 1).reshape(B_, T, -1)


def _dense_attention(q, k_all, v_all):
    B_, T = q.shape[0], q.shape[1]
    nb = T // Q_BLOCK
    qb = q.reshape((B_, nb, Q_BLOCK) + q.shape[2:]).swapaxes(0, 1)
    out = lax.map(lambda q_blk: _gqa_attend(q_blk, k_all, v_all, None, None), qb)
    return out.swapaxes(0, 1).reshape(B_, T, -1)


def _centred_dwconv(x, w, b):
    left = CONV_W // 2
    right = CONV_W - 1 - left
    L = x.shape[1]
    xp = jnp.pad(x, ((0, 0), (left, right), (0, 0)))
    out = b
    for t in range(CONV_W):
        out = out + xp[:, t:t + L] * w[t]
    return out


def _rglru_coeffs(xin, w_a, b_a, w_x, b_x, lam):
    B_, L, C = xin.shape
    xb = xin.reshape(B_, L, LRU_BLOCKS, LRU_BW)
    gate_a = jnp.einsum('blhi,hij->blhj', xb, w_a).reshape(B_, L, C) + b_a
    gate_x = jnp.einsum('blhi,hij->blhj', xb, w_x).reshape(B_, L, C) + b_x
    r = jax.nn.sigmoid(gate_a.astype(jnp.float32))
    i = jax.nn.sigmoid(gate_x.astype(jnp.float32))
    log_a = -LRU_C * r * jax.nn.softplus(-lam.astype(jnp.float32))
    a = jnp.exp(log_a)
    b = jnp.sqrt(-jnp.expm1(2.0 * log_a)) * i * xin.astype(jnp.float32)
    return a, b


def _combine(e1, e2):
    a1, b1 = e1
    a2, b2 = e2
    return a1 * a2, a2 * b1 + b2


def _linear_scan(a, b, h0, reverse):
    if h0 is not None:
        if reverse:
            b = b.at[:, -1].add(a[:, -1] * h0)
        else:
            b = b.at[:, 0].add(a[:, 0] * h0)
    _, h = lax.associative_scan(_combine, (a, b), reverse=reverse, axis=1)
    return h


def _ffn_sublayer(h, shift, scale, gate, g_pre, g_post, w_gate, w_up, w_down):
    u = _modulate(_rmsnorm(h, g_pre), shift, scale)
    y = (jax.nn.silu(u @ w_gate) * (u @ w_up)) @ w_down
    return h + FFN_RES * gate * _rmsnorm(y, g_post)


def _even_mixer(u, uc, w_in, conv_w, conv_b, w_a, b_a, w_x, b_x, lam, sink, w_out, rope, with_ctx_out):
    B_, T, _ = u.shape
    Lc = uc.shape[1]
    xa, ga, q, k, v = _split(u @ w_in, EVEN_SPLITS)
    xac, gac, qc, kc, vc = _split(uc @ w_in, EVEN_SPLITS)
    xa = _centred_dwconv(xa, conv_w, conv_b)
    xac = _centred_dwconv(xac, conv_w, conv_b)
    a_cf, b_cf = _rglru_coeffs(xac, w_a[0], b_a[0], w_x[0], b_x[0], lam[0])
    a_cb, b_cb = _rglru_coeffs(xac, w_a[1], b_a[1], w_x[1], b_x[1], lam[1])
    h_cf = _linear_scan(a_cf, b_cf, None, False)
    h_cb = _linear_scan(a_cb, b_cb, None, True)
    a_f, b_f = _rglru_coeffs(xa, w_a[0], b_a[0], w_x[0], b_x[0], lam[0])
    a_b, b_b = _rglru_coeffs(xa, w_a[1], b_a[1], w_x[1], b_x[1], lam[1])
    h_f = _linear_scan(a_f, b_f, h_cf[:, -1], False)
    h_b = _linear_scan(a_b, b_b, h_cb[:, 0], True)
    y_a = (h_f + h_b).astype(u.dtype) * jax.nn.gelu(ga)
    q = _apply_rope(q.reshape(B_, T, WIN_KV, WIN_G, WIN_HD), rope)
    k = _apply_rope(k.reshape(B_, T, WIN_KV, WIN_HD), rope)
    v = v.reshape(B_, T, WIN_KV, WIN_HD)
    kc = kc.reshape(B_, Lc, WIN_KV, WIN_HD)
    vc = vc.reshape(B_, Lc, WIN_KV, WIN_HD)
    sink_kg = sink.reshape(WIN_KV, WIN_G)
    o_b = _window_attention(q, k, v, kc, vc, sink_kg)
    y = jnp.concatenate([y_a, o_b], axis=-1) @ w_out
    if not with_ctx_out:
        return y, None
    y_ac = (h_cf + h_cb).astype(uc.dtype) * jax.nn.gelu(gac)
    o_bc = _gqa_attend(qc.reshape(B_, Lc, WIN_KV, WIN_G, WIN_HD), kc, vc, None, sink_kg).reshape(B_, Lc, -1)
    yc = jnp.concatenate([y_ac, o_bc], axis=-1) @ w_out
    return y, yc


def _odd_mixer(u, uc, w_in, q_gain, k_gain, w_out, rope, with_ctx_out):
    B_, T, _ = u.shape
    Lc = uc.shape[1]
    q, k, v = _split(u @ w_in, ODD_SPLITS)
    qc, kc, vc = _split(uc @ w_in, ODD_SPLITS)
    q = _apply_rope(_rmsnorm(q.reshape(B_, T, GLB_KV, GLB_G, GLB_HD), q_gain), rope)
    k = _apply_rope(_rmsnorm(k.reshape(B_, T, GLB_KV, GLB_HD), k_gain), rope)
    v = v.reshape(B_, T, GLB_KV, GLB_HD)
    kc = _rmsnorm(kc.reshape(B_, Lc, GLB_KV, GLB_HD), k_gain)
    vc = vc.reshape(B_, Lc, GLB_KV, GLB_HD)
    k_all = jnp.concatenate([kc, k], axis=1)
    v_all = jnp.concatenate([vc, v], axis=1)
    y = _dense_attention(q, k_all, v_all) @ w_out
    if not with_ctx_out:
        return y, None
    qc = _rmsnorm(qc.reshape(B_, Lc, GLB_KV, GLB_G, GLB_HD), q_gain)
    yc = _gqa_attend(qc, kc, vc, None, None).reshape(B_, Lc, -1) @ w_out
    return y, yc


def setup_inputs(seed: int = 0) -> dict:
    key = jax.random.key(seed)
    ks = jax.random.split(key, 32)
    D = D_MODEL

    def nrm(k, shape, scale):
        return jax.random.normal(k, shape, jnp.float32) * scale

    a0 = jax.random.uniform(ks[18], (N_EVEN, 2, LRU_WIDTH), jnp.float32, 0.9, 0.999)
    sig = a0 ** (1.0 / LRU_C)
    return {
        'x': nrm(ks[0], (BATCH, SEQ, D), 1.0),
        'c': nrm(ks[1], (BATCH, D), 1.0),
        'ctx': nrm(ks[2], (BATCH, CTX_LEN, D), 1.0),
        'c_ctx': nrm(ks[3], (D,), 1.0),
        'w_ada': nrm(ks[4], (DEPTH, D, N_MOD * D), 0.5 * D ** -0.5),
        'b_ada': nrm(ks[5], (DEPTH, N_MOD * D), 0.02),
        'norm_pre': 1.0 + nrm(ks[6], (DEPTH, N_SUB, D), 0.02),
        'norm_post': 1.0 + nrm(ks[7], (DEPTH, N_SUB, D), 0.02),
        'ffn_w_gate': nrm(ks[8], (DEPTH, 2, D, D_FF), D ** -0.5),
        'ffn_w_up': nrm(ks[9], (DEPTH, 2, D, D_FF), D ** -0.5),
        'ffn_w_down': nrm(ks[10], (DEPTH, 2, D_FF, D), D_FF ** -0.5),
        'even_w_in': nrm(ks[11], (N_EVEN, D, EVEN_IN), D ** -0.5),
        'even_conv_w': nrm(ks[12], (N_EVEN, CONV_W, LRU_WIDTH), CONV_W ** -0.5),
        'even_conv_b': nrm(ks[13], (N_EVEN, LRU_WIDTH), 0.02),
        'lru_w_a': nrm(ks[14], (N_EVEN, 2, LRU_BLOCKS, LRU_BW, LRU_BW), LRU_BW ** -0.5),
        'lru_b_a': nrm(ks[15], (N_EVEN, 2, LRU_WIDTH), 0.02),
        'lru_w_x': nrm(ks[16], (N_EVEN, 2, LRU_BLOCKS, LRU_BW, LRU_BW), LRU_BW ** -0.5),
        'lru_b_x': nrm(ks[17], (N_EVEN, 2, LRU_WIDTH), 0.02),
        'lru_lambda': jnp.log(sig) - jnp.log1p(-sig),
        'attn_sink': nrm(ks[19], (N_EVEN, WIN_HEADS), 0.5),
        'even_w_out': nrm(ks[20], (N_EVEN, EVEN_OUT, D), EVEN_OUT ** -0.5),
        'odd_w_in': nrm(ks[21], (N_ODD, D, ODD_IN), D ** -0.5),
        'odd_q_norm': 1.0 + nrm(ks[22], (N_ODD, GLB_HD), 0.02),
        'odd_k_norm': 1.0 + nrm(ks[23], (N_ODD, GLB_HD), 0.02),
        'odd_w_out': nrm(ks[24], (N_ODD, ODD_OUT, D), ODD_OUT ** -0.5),
    }


def reference(x, c, ctx, c_ctx, w_ada, b_ada, norm_pre, norm_post, ffn_w_gate, ffn_w_up, ffn_w_down,
              even_w_in, even_conv_w, even_conv_b, lru_w_a, lru_b_a, lru_w_x, lru_b_x, lru_lambda,
              attn_sink, even_w_out, odd_w_in, odd_q_norm, odd_k_norm, odd_w_out):
    B_, T, D = x.shape
    rows = T // GRID_W
    pos = jnp.arange(T)
    row = jnp.repeat(jnp.arange(rows), GRID_W)
    col = pos % GRID_W
    rope_win = _axial_rope(row, col, WIN_HD)
    rope_glb = _axial_rope(row, col, GLB_HD)
    xc = ctx
    sc = jax.nn.silu(c)
    scc = jax.nn.silu(c_ctx)
    for l in range(DEPTH):
        last = l == DEPTH - 1
        mod = (sc @ w_ada[l] + b_ada[l]).reshape(B_, N_MOD, 1, D)
        mod_c = (scc @ w_ada[l] + b_ada[l]).reshape(N_MOD, 1, D)
        x = _ffn_sublayer(x, mod[:, 0], mod[:, 1], mod[:, 2], norm_pre[l, 0], norm_post[l, 0],
                          ffn_w_gate[l, 0], ffn_w_up[l, 0], ffn_w_down[l, 0])
        xc = _ffn_sublayer(xc, mod_c[0], mod_c[1], mod_c[2], norm_pre[l, 0], norm_post[l, 0],
                           ffn_w_gate[l, 0], ffn_w_up[l, 0], ffn_w_down[l, 0])
        u = _modulate(_rmsnorm(x, norm_pre[l, 1]), mod[:, 3], mod[:, 4])
        uc = _modulate(_rmsnorm(xc, norm_pre[l, 1]), mod_c[3], mod_c[4])
        i = l // 2
        if l % 2 == 0:
            y, yc = _even_mixer(u, uc, even_w_in[i], even_conv_w[i], even_conv_b[i], lru_w_a[i], lru_b_a[i],
                                lru_w_x[i], lru_b_x[i], lru_lambda[i], attn_sink[i], even_w_out[i],
                                rope_win, not last)
        else:
            y, yc = _odd_mixer(u, uc, odd_w_in[i], odd_q_norm[i], odd_k_norm[i], odd_w_out[i],
                               rope_glb, not last)
        x = x + mod[:, 5] * _rmsnorm(y, norm_post[l, 1])
        x = _ffn_sublayer(x, mod[:, 6], mod[:, 7], mod[:, 8], norm_pre[l, 2], norm_post[l, 2],
                          ffn_w_gate[l, 1], ffn_w_up[l, 1], ffn_w_down[l, 1])
        if not last:
            xc = xc + mod_c[5] * _rmsnorm(yc, norm_post[l, 1])
            xc = _ffn_sublayer(xc, mod_c[6], mod_c[7], mod_c[8], norm_pre[l, 2], norm_post[l, 2],
                               ffn_w_gate[l, 1], ffn_w_up[l, 1], ffn_w_down[l, 1])
    return x
```

```cpp
#include <hip/hip_runtime.h>
#include <hip/hip_cooperative_groups.h>
#include <cstdio>
#include <cstdint>
namespace cg = cooperative_groups;

#ifndef MK_SINGLE
#define MK_SINGLE 1
#endif

#ifndef FUSE_ROWPASS
#define FUSE_ROWPASS 0
#endif
#ifndef CTX_KSPLIT
#define CTX_KSPLIT 1
#endif
#ifndef CTX_SHARE32
#define CTX_SHARE32 0
#endif
#ifndef CTX_SHARE16
#define CTX_SHARE16 0
#endif
#ifndef REP_GEMM
#define REP_GEMM 1
#endif
#ifndef REP_LRU
#define REP_LRU 1
#endif
#ifndef REP_MISC
#define REP_MISC 1
#endif
#ifndef REP_BAR
#define REP_BAR 1
#endif
#ifndef REP_ATT
#define REP_ATT 1
#endif
constexpr int DM = 1024, NB = 4, SEQ = 8192, LCX = 256, SEG = SEQ + LCX  , MROWS = NB * SEG  ;
constexpr int FF = 2816, NGU = 2 * FF, DEPTH = 4, NMOD = 9;
constexpr int EVEN_IN = 1792, ODD_IN = 1536, LRUW = 512;
constexpr float EPS = 1e-6f;
constexpr int NCHUNK = SEG / 64;

__device__ __forceinline__ int tidx() { int t = threadIdx.x; asm volatile("" : "+v"(t)); return t; }
__device__ __forceinline__ int bidx() { int b = blockIdx.x; asm volatile("" : "+s"(b)); return b; }

typedef unsigned wt_u32x4 __attribute__((ext_vector_type(4)));
typedef float wt_f32x4 __attribute__((ext_vector_type(4)));
#ifndef WT_STORES
#define WT_STORES 0
#endif
__device__ __forceinline__ void st16_wt(void* ptr, wt_u32x4 v) {
#if WT_STORES
    asm volatile("global_store_dwordx4 %0, %1, off sc1\n\ts_nop 1" :: "v"(ptr), "v"(v) : "memory");
#else
    *(wt_u32x4*)ptr = v;
#endif
}
__device__ __forceinline__ void st16f_wt(void* ptr, wt_f32x4 v) {
#if WT_STORES
    asm volatile("global_store_dwordx4 %0, %1, off sc1\n\ts_nop 1" :: "v"(ptr), "v"(v) : "memory");
#else
    *(wt_f32x4*)ptr = v;
#endif
}
__device__ __forceinline__ void st8_wt(void* ptr, unsigned long long v) {
#if WT_STORES
    asm volatile("global_store_dwordx2 %0, %1, off sc1\n\ts_nop 1" :: "v"(ptr), "v"(v) : "memory");
#else
    *(unsigned long long*)ptr = v;
#endif
}

namespace pg8 {
#define PG8_LAS __attribute__((address_space(3)))
typedef unsigned short bf16_t;
typedef short bf16x8 __attribute__((ext_vector_type(8)));
typedef float f32x4 __attribute__((ext_vector_type(4)));
typedef unsigned u32x4 __attribute__((ext_vector_type(4)));
constexpr int BM = 256, BK = 64, HALF = 128, HTB = HALF * BK * 2  , STAGE_BYTES = 8 * HTB, NXCD = 8, WGM = 8;

__host__ __device__ __forceinline__ int lds_byte(int r, int c) { const int st = (r >> 4) * 2 + (c >> 5), rr = r & 15, cc = c & 31, ob = rr * 64 + cc * 2; return st * 1024 + (ob ^ (((ob >> 9) & 1) << 5)); }
__host__ __device__ __forceinline__ void stage_rc(int b, int& R, int& C) { const int st = b / 1024, sb = b % 1024, swz = sb ^ (((sb >> 9) & 1) << 5); R = (st >> 1) * 16 + swz / 64; C = (st & 1) * 32 + (swz % 64) / 2; }
__host__ __device__ __forceinline__ int perm32(int rho) { const int n = rho >> 4, i = rho & 15; return 8 * (i >> 2) + 4 * n + (i & 3); }

struct Unit { int pm, pn; };
struct Gemm { const bf16_t* A; const bf16_t* Bt; int M, N, K, ld; };

struct StaticOrder {
    int nM, nN, nwg, G, c;
    __host__ __device__ void init(int M, int N, int G_, int c_) { nM = M / BM; nN = N / BM; nwg = nM * nN; G = G_; c = c_; }
    __host__ __device__ bool next(int i, Unit& u) const {
        const long L = (long)i * G + c; if (L >= nwg) return false;
        int wgid = (int)L; { const int q = nwg / NXCD, r = nwg % NXCD, xcd = wgid % NXCD, off = wgid / NXCD; wgid = (xcd < r ? xcd * (q + 1) : r * (q + 1) + (xcd - r) * q) + off; }
        const int nig = WGM * nN, gid = wgid / nig, fm = gid * WGM, gsz = (nM - fm) < WGM ? (nM - fm) : WGM;
        u.pm = fm + ((wgid % nig) % gsz); u.pn = (wgid % nig) / gsz; return true;
    }
    __device__ __forceinline__ void a_ready(const Unit&) const {}
    __device__ __forceinline__ void done(const Unit&) const {}
};

__device__ __forceinline__ unsigned cvt_pk_bf16(float lo, float hi) { unsigned r; asm volatile("v_cvt_pk_bf16_f32 %0, %1, %2" : "=v"(r) : "v"(lo), "v"(hi)); return r; }
typedef float f32x2 __attribute__((ext_vector_type(2)));
struct EpiBf16 {
    static constexpr bool PERM = true, AFTER_DRAIN = false;
    bf16_t* O; int ldc;
    __device__ __forceinline__ void operator()(const f32x4 (&acc)[2][2][4][2], const Unit& u, int wr, int wc, int fr, int fq) const {
        const int row0 = u.pm * BM + wr * 64 + fr, col0 = u.pn * BM + wc * 32 + 8 * fq;
#pragma unroll
        for (int ai = 0; ai < 2; ++ai)
#pragma unroll
            for (int m = 0; m < 4; ++m) { bf16_t* rowp = O + (size_t)(row0 + ai * HALF + m * 16) * ldc + col0;
#pragma unroll
                for (int bj = 0; bj < 2; ++bj) { const f32x4 v0 = acc[ai][bj][m][0], v1 = acc[ai][bj][m][1];
                    u32x4 w; w.x = cvt_pk_bf16(v0[0], v0[1]); w.y = cvt_pk_bf16(v0[2], v0[3]); w.z = cvt_pk_bf16(v1[0], v1[1]); w.w = cvt_pk_bf16(v1[2], v1[3]);
                    st16_wt(rowp + bj * HALF, w); } }
    }
};
struct EpiF32 {
    static constexpr bool PERM = true, AFTER_DRAIN = false;
    float* O; int ldc;
    __device__ __forceinline__ void operator()(const f32x4 (&acc)[2][2][4][2], const Unit& u, int wr, int wc, int fr, int fq) const {
        const int row0 = u.pm * BM + wr * 64 + fr, col0 = u.pn * BM + wc * 32 + 8 * fq;
#pragma unroll
        for (int ai = 0; ai < 2; ++ai)
#pragma unroll
            for (int m = 0; m < 4; ++m) { float* rowp = O + (size_t)(row0 + ai * HALF + m * 16) * ldc + col0;
#pragma unroll
                for (int bj = 0; bj < 2; ++bj) { *(f32x4*)(rowp + bj * HALF) = acc[ai][bj][m][0]; *(f32x4*)(rowp + bj * HALF + 4) = acc[ai][bj][m][1]; } }
    }
};
__device__ __forceinline__ float silu_mul(float g, float u) { return g * __builtin_amdgcn_rcpf(1.0f + __expf(-g)) * u; }
struct EpiSwiglu {
    static constexpr bool PERM = true, AFTER_DRAIN = false;
    bf16_t* O; int ldc;
    __device__ __forceinline__ void operator()(const f32x4 (&acc)[2][2][4][2], const Unit& u, int wr, int wc, int fr, int fq) const {
        const int row0 = u.pm * BM + wr * 64 + fr, col0 = u.pn * HALF + wc * 32 + 8 * fq;
#pragma unroll
        for (int ai = 0; ai < 2; ++ai)
#pragma unroll
            for (int m = 0; m < 4; ++m) { bf16_t* rowp = O + (size_t)(row0 + ai * HALF + m * 16) * ldc + col0;
                const f32x4 g0 = acc[ai][0][m][0], g1 = acc[ai][0][m][1], u0 = acc[ai][1][m][0], u1 = acc[ai][1][m][1];
                u32x4 w; w.x = cvt_pk_bf16(silu_mul(g0[0], u0[0]), silu_mul(g0[1], u0[1])); w.y = cvt_pk_bf16(silu_mul(g0[2], u0[2]), silu_mul(g0[3], u0[3]));
                w.z = cvt_pk_bf16(silu_mul(g1[0], u1[0]), silu_mul(g1[1], u1[1])); w.w = cvt_pk_bf16(silu_mul(g1[2], u1[2]), silu_mul(g1[3], u1[3]));
                st16_wt(rowp, w); }
    }
};

struct OrderX {
    StaticOrder so; int skipctx;
    __device__ void init(int M, int N, int G_, int c_, bool skip) { so.init(skip ? M - 4 * BM : M, N, G_, c_); skipctx = skip ? 1 : 0; }
    __device__ bool next(int i, Unit& u) const { const bool ok = so.next(i, u); if (ok && skipctx) u.pm = u.pm + u.pm / 32 + 1; return ok; }
    __device__ __forceinline__ void a_ready(const Unit&) const {}
    __device__ __forceinline__ void done(const Unit&) const {}
};
struct OrderCtx2 {
    int c;
    __device__ bool next(int i, Unit& u) const { if (i != 0 || c >= 32) return false; u.pm = c >> 3; u.pn = (c >> 1) & 3; return true; }
    __device__ __forceinline__ void a_ready(const Unit&) const {}
    __device__ __forceinline__ void done(const Unit&) const {}
};
struct OrderCtx {
    int c;
    __device__ bool next(int i, Unit& u) const { if (i != 0 || c >= 16) return false; u.pm = 33 * (c >> 2); u.pn = c & 3; return true; }
    __device__ __forceinline__ void a_ready(const Unit&) const {}
    __device__ __forceinline__ void done(const Unit&) const {}
};
template <class Epi, class Sched, bool ALIGN_EPI = false, bool SP2 = false>
__device__ __forceinline__ void gemm_phase(PG8_LAS unsigned char* lds, const Gemm g, const Sched& S, const Epi& E) {
    const int tid = tidx(), wid = __builtin_amdgcn_readfirstlane(tid >> 6), lane = tid & 63, wr = wid >> 2, wc = wid & 3, fr = lane & 15, fq = lane >> 4;
    const int K = g.K, nt = K / BK, LD = g.ld ? g.ld : g.K;
    unsigned voffA[2], voffB[2];
#pragma unroll
    for (int i = 0; i < 2; ++i) { int R, C; stage_rc(tid * 16 + i * 8192, R, C); const int Rb = Epi::PERM ? ((R & ~31) + perm32(R & 31)) : R;
        voffA[i] = (unsigned)(R * LD + C) * 2u; voffB[i] = (unsigned)(Rb * LD + C) * 2u; }
    const size_t kstep = (size_t)(BK * 2);
    const size_t hstep = (size_t)HALF * LD * 2;
    const size_t tstep = 2 * hstep;
    const unsigned ldsw = (unsigned)wid * 1024u;
    const int aoff = lds_byte(wr * 64 + fr, fq * 8), boff = lds_byte(wc * 32 + fr, fq * 8);
#define PG8_SA(b, h) (((b) * 2 + (h)) * HTB)
#define PG8_SB(b, h) ((4 + (b) * 2 + (h)) * HTB)
#define PG8_STAGE(bufoff, gbase, voff) do { _Pragma("unroll") for (int _i = 0; _i < 2; ++_i) \
        __builtin_amdgcn_global_load_lds((const unsigned*)((const char*)(gbase) + (voff)[_i]), (PG8_LAS unsigned*)(lds + (bufoff) + ldsw + _i * 8192), 16, 0, 0); } while (0)
#define PG8_LDA(dst, b, h) do { _Pragma("unroll") for (int m = 0; m < 4; ++m) _Pragma("unroll") for (int k = 0; k < 2; ++k) dst[m][k] = *(const PG8_LAS bf16x8*)(lds + PG8_SA(b, h) + aoff + m * 2048 + k * 1024); } while (0)
#define PG8_LDB(dst, b, h) do { _Pragma("unroll") for (int n = 0; n < 2; ++n) _Pragma("unroll") for (int k = 0; k < 2; ++k) dst[n][k] = *(const PG8_LAS bf16x8*)(lds + PG8_SB(b, h) + boff + n * 2048 + k * 1024); } while (0)
#define PG8_MMA(ai, bj, At, Bt) do { __builtin_amdgcn_s_setprio(1); _Pragma("unroll") for (int m = 0; m < 4; ++m) _Pragma("unroll") for (int n = 0; n < 2; ++n) _Pragma("unroll") for (int k = 0; k < 2; ++k) \
        acc[ai][bj][m][n] = __builtin_amdgcn_mfma_f32_16x16x32_bf16(Bt[n][k], At[m][k], acc[ai][bj][m][n], 0, 0, 0); __builtin_amdgcn_s_setprio(0); } while (0)
#define PG8_WAIT_V(n) asm volatile("s_waitcnt vmcnt(" #n ")" ::: "memory")
#define PG8_WAIT_L(n) asm volatile("s_waitcnt lgkmcnt(" #n ")" ::: "memory")
#define PG8_BAR __builtin_amdgcn_s_barrier()
#define PG8_SCHED __builtin_amdgcn_sched_barrier(0)
    Unit cur, nxt; int ui = 0;
    if (!S.next(0, cur)) return;
    f32x4 acc[2][2][4][2];
#pragma unroll
    for (int a = 0; a < 2; ++a)
#pragma unroll
        for (int b = 0; b < 2; ++b)
#pragma unroll
            for (int m = 0; m < 4; ++m)
#pragma unroll
                for (int n = 0; n < 2; ++n) acc[a][b][m][n] = (f32x4){0.f, 0.f, 0.f, 0.f};
    bf16x8 At[4][2], B0[2][2], B1[2][2];
    const char* cA = (const char*)g.A + (size_t)cur.pm * tstep; const char* cB = (const char*)g.Bt + (size_t)cur.pn * tstep;
    S.a_ready(cur);
    if constexpr (SP2) {
        PG8_STAGE(PG8_SB(0, 0), cB, voffB); PG8_STAGE(PG8_SB(0, 1), cB + hstep, voffB); PG8_STAGE(PG8_SA(0, 0), cA, voffA); PG8_STAGE(PG8_SA(0, 1), cA + hstep, voffA);
        if (wr == 1) PG8_BAR;
        PG8_WAIT_V(2); PG8_BAR;
        PG8_STAGE(PG8_SB(1, 0), cB + kstep, voffB); PG8_STAGE(PG8_SA(1, 0), cA + kstep, voffA); PG8_STAGE(PG8_SB(1, 1), cB + hstep + kstep, voffB);
        PG8_WAIT_V(6); PG8_BAR;
    } else {
        PG8_STAGE(PG8_SB(0, 0), cB, voffB); PG8_STAGE(PG8_SA(0, 0), cA, voffA); PG8_STAGE(PG8_SB(0, 1), cB + hstep, voffB); PG8_STAGE(PG8_SA(0, 1), cA + hstep, voffA);
        if (wr == 1) PG8_BAR;
        PG8_WAIT_V(4); PG8_BAR;
        PG8_STAGE(PG8_SB(1, 0), cB + kstep, voffB); PG8_STAGE(PG8_SA(1, 0), cA + kstep, voffA); PG8_STAGE(PG8_SB(1, 1), cB + hstep + kstep, voffB);
        PG8_WAIT_V(6); PG8_BAR;
    }
    for (;;) {
        const bool has_next = S.next(ui + 1, nxt);
        const char* nA = has_next ? (const char*)g.A + (size_t)nxt.pm * tstep : cA; const char* nB = has_next ? (const char*)g.Bt + (size_t)nxt.pn * tstep : cB;
        for (int t = 0; t < nt; t += 2) {
            const bool last = (t == nt - 2);
            const char* a1 = cA + (size_t)(t + 1) * kstep;
            const char* a2 = last ? nA : cA + (size_t)(t + 2) * kstep; const char* b2 = last ? nB : cB + (size_t)(t + 2) * kstep;
            const char* a3 = a2 + kstep; const char* b3 = b2 + kstep;
            if (last && has_next) S.a_ready(nxt);
            if constexpr (SP2) {
            PG8_LDB(B0, 0, 0); PG8_LDB(B1, 0, 1); PG8_SCHED; PG8_LDA(At, 0, 0); PG8_STAGE(PG8_SA(1, 1), a1 + hstep, voffA);
            PG8_WAIT_V(8); PG8_WAIT_L(0); PG8_BAR; PG8_MMA(0, 0, At, B0); PG8_MMA(0, 1, At, B1); PG8_BAR; PG8_SCHED;
            PG8_LDA(At, 0, 1); PG8_STAGE(PG8_SB(0, 0), b2, voffB); PG8_STAGE(PG8_SB(0, 1), b2 + hstep, voffB); PG8_STAGE(PG8_SA(0, 0), a2, voffA);
            PG8_WAIT_V(8); PG8_WAIT_L(0); PG8_BAR; PG8_MMA(1, 0, At, B0); PG8_MMA(1, 1, At, B1); PG8_BAR; PG8_SCHED;
            PG8_LDB(B0, 1, 0); PG8_LDB(B1, 1, 1); PG8_SCHED; PG8_LDA(At, 1, 0); PG8_STAGE(PG8_SA(0, 1), a2 + hstep, voffA);
            PG8_WAIT_V(8); PG8_WAIT_L(0); PG8_BAR; PG8_MMA(0, 0, At, B0); PG8_MMA(0, 1, At, B1); PG8_BAR; PG8_SCHED;
            PG8_LDA(At, 1, 1); PG8_STAGE(PG8_SB(1, 0), b3, voffB); PG8_STAGE(PG8_SB(1, 1), b3 + hstep, voffB); PG8_STAGE(PG8_SA(1, 0), a3, voffA);
            PG8_WAIT_V(8); PG8_WAIT_L(0); PG8_BAR; PG8_MMA(1, 0, At, B0); PG8_MMA(1, 1, At, B1); PG8_BAR; PG8_SCHED;
            } else {
            PG8_LDB(B0, 0, 0); PG8_SCHED; PG8_LDA(At, 0, 0); PG8_STAGE(PG8_SA(1, 1), a1 + hstep, voffA);
            PG8_WAIT_L(8); PG8_BAR; PG8_WAIT_L(0); PG8_MMA(0, 0, At, B0); PG8_BAR; PG8_SCHED;
            PG8_LDB(B1, 0, 1); PG8_STAGE(PG8_SB(0, 0), b2, voffB);
            PG8_BAR; PG8_WAIT_L(0); PG8_MMA(0, 1, At, B1); PG8_BAR;
            PG8_LDA(At, 0, 1); PG8_STAGE(PG8_SA(0, 0), a2, voffA);
            PG8_BAR; PG8_WAIT_L(0); PG8_MMA(1, 0, At, B0); PG8_BAR; PG8_SCHED;
            PG8_STAGE(PG8_SB(0, 1), b2 + hstep, voffB);
            PG8_WAIT_V(6); PG8_BAR; PG8_MMA(1, 1, At, B1); PG8_BAR;
            PG8_LDB(B0, 1, 0); PG8_SCHED; PG8_LDA(At, 1, 0); PG8_STAGE(PG8_SA(0, 1), a2 + hstep, voffA);
            PG8_WAIT_L(8); PG8_BAR; PG8_WAIT_L(0); PG8_MMA(0, 0, At, B0); PG8_BAR; PG8_SCHED;
            PG8_LDB(B1, 1, 1); PG8_STAGE(PG8_SB(1, 0), b3, voffB);
            PG8_BAR; PG8_WAIT_L(0); PG8_MMA(0, 1, At, B1); PG8_BAR;
            PG8_LDA(At, 1, 1); PG8_STAGE(PG8_SA(1, 0), a3, voffA);
            PG8_BAR; PG8_WAIT_L(0); PG8_MMA(1, 0, At, B0); PG8_BAR; PG8_SCHED;
            PG8_STAGE(PG8_SB(1, 1), b3 + hstep, voffB);
            PG8_WAIT_V(6); PG8_BAR; PG8_MMA(1, 1, At, B1); PG8_BAR;
            }
        }
        if constexpr (ALIGN_EPI) { if (wr == 0) PG8_BAR; }
        if constexpr (!Epi::AFTER_DRAIN) { E(acc, cur, wr, wc, fr, fq); S.done(cur); }
        if (!has_next) break;
#pragma unroll
        for (int a = 0; a < 2; ++a)
#pragma unroll
            for (int b = 0; b < 2; ++b)
#pragma unroll
                for (int m = 0; m < 4; ++m)
#pragma unroll
                    for (int n = 0; n < 2; ++n) acc[a][b][m][n] = (f32x4){0.f, 0.f, 0.f, 0.f};
        cur = nxt; cA = nA; cB = nB; ++ui;
        if constexpr (ALIGN_EPI) { if (wr == 1) PG8_BAR; }
    }
    PG8_WAIT_V(0);
    if constexpr (!ALIGN_EPI) { if (wr == 0) PG8_BAR; }
    PG8_BAR;
    if constexpr (Epi::AFTER_DRAIN) { E.fused(acc, cur, wr, wc, fr, fq, lds, wid, lane); S.done(cur); }
#undef PG8_SA
#undef PG8_SB
#undef PG8_STAGE
#undef PG8_LDA
#undef PG8_LDB
#undef PG8_MMA
#undef PG8_WAIT_V
#undef PG8_WAIT_L
#undef PG8_BAR
#undef PG8_SCHED
}
}
namespace att {
using bf16 = unsigned short;
using bf16x8 = __attribute__((ext_vector_type(8))) short;
using s16x4  = __attribute__((ext_vector_type(4))) short;
using f32x16 = __attribute__((ext_vector_type(16))) float;
using u32x4  = __attribute__((ext_vector_type(4))) unsigned;
constexpr int NW = 8, QBLK = 32, KVBLK = 64;
constexpr float THR = 8.f;
#define ATT_SBAR() __builtin_amdgcn_sched_barrier(0)
__device__ __forceinline__ int crow(int r, int hi) { return (r & 3) + 8 * (r >> 2) + 4 * hi; }
__device__ __forceinline__ unsigned cvtpk(float lo, float hi) { unsigned r; asm volatile("v_cvt_pk_bf16_f32 %0, %1, %2" : "=v"(r) : "v"(lo), "v"(hi)); return r; }
template <int DH> struct Cfg {
    static constexpr int ND = DH / 16, NO = DH / 32, NCB = DH / 32, NLD = DH / 64, CPR = DH / 8, ROWB = DH * 2;
    static constexpr int SHM_T = KVBLK * DH * 2;
    static constexpr int SHM = 4 * SHM_T + NW * 64 * 4;
    static constexpr float SCALE = DH == 64 ? 0.125f : 0.088388347648318440f;
    static constexpr float C = SCALE * 1.4426950408889634f;
};
template <int DH> __device__ __forceinline__ int kswz(int row, int colB) { return row * Cfg<DH>::ROWB + (colB ^ ((row & 7) << 4)); }

template <int DH> __device__ __forceinline__ void partialSM(f32x16& p0, f32x16& p1, float& m_reg, float& mn, float& alpha) {
    constexpr float C = Cfg<DH>::C, SCALE = Cfg<DH>::SCALE;
    float pmax = p0[0];
#pragma unroll
    for (int r = 1; r < 16; ++r) pmax = fmaxf(pmax, p0[r]);
#pragma unroll
    for (int r = 0; r < 16; ++r) pmax = fmaxf(pmax, p1[r]);
    { auto rr = __builtin_amdgcn_permlane32_swap(__float_as_uint(pmax), __float_as_uint(pmax), false, false);
      pmax = fmaxf(__uint_as_float(rr[0]), __uint_as_float(rr[1])); }
    if (__builtin_expect(__all(pmax - m_reg <= THR / SCALE), 1)) { mn = m_reg; alpha = 1.f; }
    else { mn = fmaxf(m_reg, pmax); alpha = __builtin_amdgcn_exp2f((m_reg - mn) * C); m_reg = mn; }
    const float mnC = -mn * C;
#pragma unroll
    for (int r = 0; r < 16; ++r) p0[r] = fmaf(p0[r], C, mnC);
#pragma unroll
    for (int r = 0; r < 16; ++r) p1[r] = fmaf(p1[r], C, mnC);
#pragma unroll
    for (int r = 0; r < 16; ++r) p0[r] = __builtin_amdgcn_exp2f(p0[r]);
}
__device__ __forceinline__ void finishSM(f32x16& p0, f32x16& p1, float alpha, float& l_reg, bf16x8& pa0, bf16x8& pa1, bf16x8& pa2, bf16x8& pa3) {
#pragma unroll
    for (int r = 0; r < 16; ++r) p1[r] = __builtin_amdgcn_exp2f(p1[r]);
    float ps = 0;
#pragma unroll
    for (int r = 0; r < 16; ++r) ps += p0[r];
#pragma unroll
    for (int r = 0; r < 16; ++r) ps += p1[r];
    { auto rr = __builtin_amdgcn_permlane32_swap(__float_as_uint(ps), __float_as_uint(ps), false, false);
      ps = __uint_as_float(rr[0]) + __uint_as_float(rr[1]); }
    l_reg = l_reg * alpha + ps;
#define ATT_PK4(P, BASE, OUT) do { unsigned a0 = cvtpk(P[BASE + 0], P[BASE + 1]), a1 = cvtpk(P[BASE + 2], P[BASE + 3]);   \
    unsigned b0 = cvtpk(P[BASE + 4], P[BASE + 5]), b1 = cvtpk(P[BASE + 6], P[BASE + 7]);                              \
    auto r0 = __builtin_amdgcn_permlane32_swap(a0, b0, false, false); auto r1 = __builtin_amdgcn_permlane32_swap(a1, b1, false, false); \
    u32x4 w = {r0[0], r1[0], r0[1], r1[1]}; OUT = *reinterpret_cast<bf16x8*>(&w); } while (0)
    ATT_PK4(p0, 0, pa0); ATT_PK4(p0, 8, pa1); ATT_PK4(p1, 0, pa2); ATT_PK4(p1, 8, pa3);
#undef ATT_PK4
}
template <int DH> __device__ __forceinline__ void qkt(f32x16& p0, f32x16& p1, const char* Ks, const bf16x8* qr, int r32, int hi) {
    p0 = f32x16{}; p1 = f32x16{};
#pragma unroll
    for (int d0 = 0; d0 < Cfg<DH>::ND; ++d0) { const int cb = (d0 * 16 + hi * 8) * 2;
        const bf16x8 b0 = *reinterpret_cast<const bf16x8*>(Ks + kswz<DH>(r32, cb));
        const bf16x8 b1 = *reinterpret_cast<const bf16x8*>(Ks + kswz<DH>(32 + r32, cb));
        p0 = __builtin_amdgcn_mfma_f32_32x32x16_bf16(b0, qr[d0], p0, 0, 0, 0);
        p1 = __builtin_amdgcn_mfma_f32_32x32x16_bf16(b1, qr[d0], p1, 0, 0, 0); }
}
__device__ __forceinline__ void maskp(f32x16& p0, f32x16& p1, int kb, int qpos, int hi) {
    const int d0 = kb + 4 * hi - qpos;
#pragma unroll
    for (int r = 0; r < 16; ++r) { const int d = d0 + (r & 3) + 8 * (r >> 2);
        if (d > 128 || d < -128) p0[r] = -INFINITY;
        if (d + 32 > 128 || d + 32 < -128) p1[r] = -INFINITY; }
}
template <int DH> __device__ __forceinline__ int v_st(int k, int c) { const int kk = (k & ~0xC) | ((k & 4) << 1) | ((k & 8) >> 1); return ((kk >> 3) * Cfg<DH>::NCB + (c >> 5)) * 512 + ((kk & 7) * 32 + (c & 31)) * 2; }
__device__ __forceinline__ int v_rd_base(int lane) { return ((lane & 3) << 3) | (((lane >> 2) & 3) << 6) | (((lane >> 4) & 1) << 5) | (((lane >> 5) & 1) << 8); }
template <int OFF> __device__ __forceinline__ s16x4 tr_read(int vb) { s16x4 r; asm volatile("ds_read_b64_tr_b16 %0, %1 offset:%2" : "=&v"(r) : "v"(vb), "i"(OFF) : "memory"); return r; }
template <int DH, int D0> __device__ __forceinline__ void pv_one(f32x16& od, int vb, bf16x8 pa0, bf16x8 pa1, bf16x8 pa2, bf16x8 pa3) {
    constexpr int KS = Cfg<DH>::NCB * 1024, HF = Cfg<DH>::NCB * 512, B0 = D0 * 512;
    const s16x4 l0 = tr_read<B0>(vb), h0 = tr_read<B0 + HF>(vb), l1 = tr_read<B0 + KS>(vb), h1 = tr_read<B0 + KS + HF>(vb);
    const s16x4 l2 = tr_read<B0 + 2 * KS>(vb), h2 = tr_read<B0 + 2 * KS + HF>(vb), l3 = tr_read<B0 + 3 * KS>(vb), h3 = tr_read<B0 + 3 * KS + HF>(vb);
    asm volatile("s_waitcnt lgkmcnt(0)" ::: "memory"); ATT_SBAR();
#define ATT_PK(L, H) (bf16x8){L[0], L[1], L[2], L[3], H[0], H[1], H[2], H[3]}
    od = __builtin_amdgcn_mfma_f32_32x32x16_bf16(pa0, ATT_PK(l0, h0), od, 0, 0, 0);
    od = __builtin_amdgcn_mfma_f32_32x32x16_bf16(pa1, ATT_PK(l1, h1), od, 0, 0, 0);
    od = __builtin_amdgcn_mfma_f32_32x32x16_bf16(pa2, ATT_PK(l2, h2), od, 0, 0, 0);
    od = __builtin_amdgcn_mfma_f32_32x32x16_bf16(pa3, ATT_PK(l3, h3), od, 0, 0, 0);
#undef ATT_PK
}
template <int DH> __device__ __forceinline__ void pv_all(f32x16* o, int vb, bf16x8 pa0, bf16x8 pa1, bf16x8 pa2, bf16x8 pa3) {
    pv_one<DH, 0>(o[0], vb, pa0, pa1, pa2, pa3); pv_one<DH, 1>(o[1], vb, pa0, pa1, pa2, pa3);
    if constexpr (DH == 128) { pv_one<DH, 2>(o[2], vb, pa0, pa1, pa2, pa3); pv_one<DH, 3>(o[3], vb, pa0, pa1, pa2, pa3); }
}

template <int DH, int LDQ, int LDK, int LDO, int VOFF, bool MASK, int QPREP, int HS = 256>
__device__ __forceinline__ void attn_body(const bf16* __restrict__ Qb, const bf16* __restrict__ Kh, bf16* __restrict__ Ob,
                                          int NT, int band0, int q0, float sinkl2, const float* __restrict__ qgain, const float* __restrict__ qtab, char* lds, float sinkl2b = 0.f) {
    using CF = Cfg<DH>;
    constexpr int SHM_T = CF::SHM_T, NLD = CF::NLD, CPR = CF::CPR, NO = CF::NO, ND = CF::ND, SD = 2;
    const int tid = tidx(), wid = tid >> 6, lane = tid & 63, r32 = lane & 31, hi = lane >> 5;
    constexpr int WPH = HS / QBLK; const int hsel = wid / WPH, wrow = (wid % WPH) * QBLK;
    char* V_lds = lds; char* K_lds = lds + 2 * SHM_T;
    float* wsf = (float*)(lds + 4 * SHM_T) + wid * 64; float* li_l = wsf; float* al_l = wsf + 32;
    float m_reg = -1e30f, l_reg = 0; f32x16 o[NO]; bf16x8 qr[ND];
#pragma unroll
    for (int d = 0; d < NO; ++d) o[d] = f32x16{};
    const bf16* Qw = Qb + hsel * DH + (long)(wrow + r32) * LDQ + hi * 8;
#pragma unroll
    for (int d0 = 0; d0 < ND; ++d0) qr[d0] = *reinterpret_cast<const bf16x8*>(Qw + d0 * 16);
    if constexpr (QPREP != 0) {
        float qf[ND][8];
#pragma unroll
        for (int d0 = 0; d0 < ND; ++d0)
#pragma unroll
            for (int e = 0; e < 8; ++e) { const unsigned short hv = (unsigned short)qr[d0][e]; qf[d0][e] = __uint_as_float((unsigned)hv << 16); }
        if constexpr ((QPREP & 2) != 0) {
            float ss = 0.f;
#pragma unroll
            for (int d0 = 0; d0 < ND; ++d0)
#pragma unroll
                for (int e = 0; e < 8; ++e) ss += qf[d0][e] * qf[d0][e];
            { auto rr = __builtin_amdgcn_permlane32_swap(__float_as_uint(ss), __float_as_uint(ss), false, false); ss = __uint_as_float(rr[0]) + __uint_as_float(rr[1]); }
            const float rs = rsqrtf(ss * (1.0f / DH) + 1e-6f);
#pragma unroll
            for (int d0 = 0; d0 < ND; ++d0) { const float4 g0 = *reinterpret_cast<const float4*>(qgain + d0 * 16 + hi * 8), g1 = *reinterpret_cast<const float4*>(qgain + d0 * 16 + hi * 8 + 4);
                qf[d0][0] *= rs * g0.x; qf[d0][1] *= rs * g0.y; qf[d0][2] *= rs * g0.z; qf[d0][3] *= rs * g0.w; qf[d0][4] *= rs * g1.x; qf[d0][5] *= rs * g1.y; qf[d0][6] *= rs * g1.z; qf[d0][7] *= rs * g1.w; }
        }
        if constexpr ((QPREP & 1) != 0) {
            const float* tb = qtab + ((long)(wrow + r32) * (DH / 2) + hi * 4) * 2;
#pragma unroll
            for (int d0 = 0; d0 < ND; ++d0) { const float4 t0 = *reinterpret_cast<const float4*>(tb + d0 * 16), t1 = *reinterpret_cast<const float4*>(tb + d0 * 16 + 4);
                const float c[4] = {t0.x, t0.z, t1.x, t1.z}, sn[4] = {t0.y, t0.w, t1.y, t1.w};
#pragma unroll
                for (int i = 0; i < 4; ++i) { const float a = qf[d0][2 * i], b = qf[d0][2 * i + 1]; qf[d0][2 * i] = a * c[i] - b * sn[i]; qf[d0][2 * i + 1] = a * sn[i] + b * c[i]; } }
        }
#pragma unroll
        for (int d0 = 0; d0 < ND; ++d0) { u32x4 w = {cvtpk(qf[d0][0], qf[d0][1]), cvtpk(qf[d0][2], qf[d0][3]), cvtpk(qf[d0][4], qf[d0][5]), cvtpk(qf[d0][6], qf[d0][7])}; qr[d0] = *reinterpret_cast<bf16x8*>(&w); }
    }
    const int sr0 = tid / CPR, sc0 = (tid % CPR) * 8, goff0 = sr0 * LDK + sc0, vst0 = v_st<DH>(sr0, sc0), kst0 = kswz<DH>(sr0, sc0 * 2);
    constexpr int RSTEP = 512 / CPR, GSTEP = RSTEP * LDK, VSTEP = (RSTEP >> 3) * CF::NCB * 512, KSTEP = RSTEP * CF::ROWB;
    static_assert(NLD == 1 || (RSTEP % 16 == 0), "piece step keeps the row's low four bits (V key-bit swap and K swizzle unchanged)");
    const int vb0 = (int)(uintptr_t)V_lds + v_rd_base(lane);
    const int qpos = q0 + wrow + r32;
    struct { bf16x8 v[NLD], k[NLD]; } sr_[SD];
#define ATT_KROW(j) (64 * (j) + ((j) >= 4 ? band0 : 0))
#define ATT_SLOAD(i, j) do { const bf16* kp_ = Kh + (long)ATT_KROW(j) * LDK; _Pragma("unroll") for (int q_ = 0; q_ < NLD; ++q_) { \
        sr_[i].v[q_] = *reinterpret_cast<const bf16x8*>(kp_ + goff0 + q_ * GSTEP + VOFF); sr_[i].k[q_] = *reinterpret_cast<const bf16x8*>(kp_ + goff0 + q_ * GSTEP); } } while (0)
#define ATT_SWRITE(b, i) do { _Pragma("unroll") for (int q_ = 0; q_ < NLD; ++q_) { *(bf16x8*)(V_lds + (b) * SHM_T + vst0 + q_ * VSTEP) = sr_[i].v[q_]; *(bf16x8*)(K_lds + (b) * SHM_T + kst0 + q_ * KSTEP) = sr_[i].k[q_]; } } while (0)
#define ATT_SWAIT() do { if constexpr (SD == 1) asm volatile("s_waitcnt vmcnt(0)" ::: "memory"); else if constexpr (NLD == 2) asm volatile("s_waitcnt vmcnt(4)" ::: "memory"); else asm volatile("s_waitcnt vmcnt(2)" ::: "memory"); } while (0)
#define ATT_RESC(a) do { if (__any((a) < 1.f)) { if (hi == 0) al_l[r32] = (a); asm volatile("s_waitcnt lgkmcnt(0)" ::: "memory"); \
        _Pragma("unroll") for (int d = 0; d < NO; ++d) _Pragma("unroll") for (int r = 0; r < 16; ++r) o[d][r] *= al_l[crow(r, hi)]; } } while (0)
#define ATT_MASK(P0, P1, j) do { if constexpr (MASK) { if ((j) >= 4) maskp(P0, P1, band0 + 64 * ((j) - 4), qpos, hi); } } while (0)
    f32x16 pA0, pA1, pB0, pB1; float mnA, mnB, alA, alB; bf16x8 pa0, pa1, pa2, pa3;
    constexpr int SE = 0, SO = SD - 1;
    ATT_SLOAD(SE, 0); asm volatile("s_waitcnt vmcnt(0)" ::: "memory"); ATT_SWRITE(0, SE); __syncthreads();
    qkt<DH>(pA0, pA1, K_lds, qr, r32, hi); ATT_MASK(pA0, pA1, 0); partialSM<DH>(pA0, pA1, m_reg, mnA, alA);
    ATT_SLOAD(SO, 1); if constexpr (SD == 2) { if (2 < NT) ATT_SLOAD(SE, 2); }
    ATT_SWAIT(); ATT_SWRITE(1, SO); __syncthreads();
    for (int j = 1; j + 1 < NT; j += 2) {
        ATT_SBAR(); qkt<DH>(pB0, pB1, K_lds + SHM_T, qr, r32, hi); ATT_MASK(pB0, pB1, j);
        finishSM(pA0, pA1, alA, l_reg, pa0, pa1, pa2, pa3); ATT_SBAR();
        ATT_SLOAD(SO, j + SD); ATT_SBAR();
        pv_all<DH>(o, vb0, pa0, pa1, pa2, pa3); partialSM<DH>(pB0, pB1, m_reg, mnB, alB);
        __syncthreads(); ATT_SWAIT(); ATT_SWRITE(0, SE);
        ATT_RESC(alB); __syncthreads();
        ATT_SBAR(); qkt<DH>(pA0, pA1, K_lds, qr, r32, hi); ATT_MASK(pA0, pA1, j + 1);
        finishSM(pB0, pB1, alB, l_reg, pa0, pa1, pa2, pa3); ATT_SBAR();
        if (SD == 1 || j + 3 < NT) ATT_SLOAD(SE, j + 1 + SD); ATT_SBAR();
        pv_all<DH>(o, vb0 + SHM_T, pa0, pa1, pa2, pa3); partialSM<DH>(pA0, pA1, m_reg, mnA, alA);
        __syncthreads(); ATT_SWAIT(); ATT_SWRITE(1, SO);
        ATT_RESC(alA); __syncthreads();
    }
    ATT_SBAR(); qkt<DH>(pB0, pB1, K_lds + SHM_T, qr, r32, hi); ATT_MASK(pB0, pB1, NT - 1);
    finishSM(pA0, pA1, alA, l_reg, pa0, pa1, pa2, pa3); ATT_SBAR();
    pv_all<DH>(o, vb0, pa0, pa1, pa2, pa3); partialSM<DH>(pB0, pB1, m_reg, mnB, alB);
    __syncthreads(); ATT_RESC(alB);
    finishSM(pB0, pB1, alB, l_reg, pa0, pa1, pa2, pa3); ATT_SBAR();
    pv_all<DH>(o, vb0 + SHM_T, pa0, pa1, pa2, pa3);
    l_reg += __builtin_amdgcn_exp2f((hsel ? sinkl2b : sinkl2) - m_reg * CF::C);
    if (hi == 0) li_l[r32] = l_reg; asm volatile("s_waitcnt lgkmcnt(0)" ::: "memory");
    float rli[16];
#pragma unroll
    for (int r = 0; r < 16; ++r) rli[r] = __builtin_amdgcn_rcpf(li_l[crow(r, hi)]);
    bf16* Ow = Ob + hsel * DH + (long)wrow * LDO;
#pragma unroll
    for (int r = 0; r < 16; ++r) { const int orow = crow(r, hi);
#pragma unroll
        for (int d0 = 0; d0 < NO; ++d0) { const unsigned w = cvtpk(o[d0][r] * rli[r], 0.f); Ow[(long)orow * LDO + d0 * 32 + r32] = (bf16)(w & 0xffffu); } }
    __syncthreads();
#undef ATT_KROW
#undef ATT_SLOAD
#undef ATT_SWRITE
#undef ATT_SWAIT
#undef ATT_RESC
#undef ATT_MASK
}
}
#define LAS __attribute__((address_space(3)))
typedef unsigned short bf16;
typedef unsigned v4u __attribute__((ext_vector_type(4)));
typedef float f32x4 __attribute__((ext_vector_type(4)));
typedef short bf16x8 __attribute__((ext_vector_type(8)));
constexpr int NTHR = 512, NWAVES = 8, LDS_BYTES = 155648;

constexpr size_t SZ_X = (size_t)MROWS * DM * 4, SZ_A = (size_t)MROWS * FF * 2, SZ_P = (size_t)MROWS * EVEN_IN * 2, SZ_U = (size_t)MROWS * DM * 2;
constexpr size_t OFF_X = 0, OFF_Y = OFF_X + SZ_X, OFF_A = OFF_Y + SZ_X, OFF_P = OFF_A, OFF_Z = OFF_A + SZ_P, OFF_U = OFF_A + SZ_A;
static_assert(SZ_P + SZ_U == SZ_A, "Z sits in the tail of A");
constexpr size_t SZ_WGU = (size_t)NGU * DM * 2, SZ_WD = (size_t)DM * FF * 2, SZ_WIN = (size_t)EVEN_IN * DM * 2, SZ_WOUT = (size_t)DM * DM * 2, SZ_LW = (size_t)8 * 256 * 64 * 2;
constexpr size_t OFF_WGU0 = OFF_U + SZ_U, OFF_WD0 = OFF_WGU0 + SZ_WGU, OFF_WGU1 = OFF_WD0 + SZ_WD, OFF_WD1 = OFF_WGU1 + SZ_WGU, OFF_WIN = OFF_WD1 + SZ_WD, OFF_WOUT = OFF_WIN + SZ_WIN, OFF_LW = OFF_WOUT + SZ_WOUT;
constexpr size_t OFF_MOD = OFF_LW + SZ_LW, SZ_MOD = (size_t)DEPTH * 5 * NMOD * DM * 4;
constexpr size_t OFF_TABW = OFF_MOD + SZ_MOD, SZ_TABW = (size_t)SEQ * 32 * 2 * 4, OFF_TABG = OFF_TABW + SZ_TABW, SZ_TABG = (size_t)SEQ * 64 * 2 * 4;
constexpr size_t SZ_CH = (size_t)2 * NB * NCHUNK * LRUW * 4, OFF_CHA = OFF_TABG + SZ_TABG, OFF_CHB = OFF_CHA + SZ_CH, OFF_CAR = OFF_CHB + SZ_CH, WS_END = OFF_CAR + SZ_CH;
constexpr size_t OFF_CTL = (WS_END + 255) / 256 * 256, CTL_BYTES = 65536, OFF_PB = OFF_CTL + CTL_BYTES, SZ_PB = (size_t)2 * NB * LCX * DM * 4  , WS_NEED = OFF_PB + SZ_PB;
constexpr int CW_BAR = 0  , CW_PC = 4096  , CW_Q = 4096 + 132 * 64  ;
static_assert((CW_Q + 16 * 64) * 4 <= (int)CTL_BYTES, "control words");
static_assert(WS_NEED <= 603979776ull, "workspace map must fit 4x the largest input");

struct Params { const float* in[25]; float* out; unsigned char* ws; int lo, hi, rep_gemm, rep_att, rep_lru, rep_misc, rep_bar, pad; };
__device__ __forceinline__ const float* pin(const Params& p, int i) { i = __builtin_amdgcn_readfirstlane(i); asm volatile("" : "+s"(i)); return p.in[i]; }
__device__ __forceinline__ unsigned char* pws(const Params& p) { unsigned char* w = p.ws; asm volatile("" : "+s"(w)); return w; }
__device__ __forceinline__ float* pout(const Params& p) { float* w = p.out; asm volatile("" : "+s"(w)); return w; }
enum { I_X = 0, I_C, I_CTX, I_CCTX, I_WADA, I_BADA, I_NPRE, I_NPOST, I_WG, I_WU, I_WDN, I_EWIN, I_ECW, I_ECB, I_LWA, I_LBA, I_LWX, I_LBX, I_LAM, I_SINK, I_EWOUT, I_OWIN, I_OQN, I_OKN, I_OWOUT };

__device__ __forceinline__ unsigned f2bf(float f) { unsigned u = __builtin_bit_cast(unsigned, f); return (u + 0x7fffu + ((u >> 16) & 1u)) >> 16; }
__device__ __forceinline__ unsigned pk2(float lo, float hi) { return f2bf(lo) | (f2bf(hi) << 16); }
__device__ __forceinline__ float bf2f(unsigned short h) { return __builtin_bit_cast(float, (unsigned)h << 16); }
__device__ __forceinline__ float bflo(unsigned w) { return __builtin_bit_cast(float, w << 16); }
__device__ __forceinline__ float bfhi(unsigned w) { return __builtin_bit_cast(float, w & 0xffff0000u); }
__device__ __forceinline__ float wave_sum(float v) {
#pragma unroll
    for (int o = 1; o < 64; o <<= 1) v += __shfl_xor(v, o);
    return v;
}

__device__ __forceinline__ void phase_mod(const Params& p, char* lds) {
    const int tid = tidx(), wid = tid >> 6, lane = tid & 63;
    float* s = (float*)lds;
    float* red = (float*)(lds + 20480);
    for (int i = tid; i < 5 * DM; i += NTHR) { const int v = i >> 10, k = i & 1023; const float c = v < 4 ? pin(p, I_C)[v * DM + k] : pin(p, I_CCTX)[k]; s[i] = c / (1.0f + expf(-c)); }
    __syncthreads();
    float* MOD = (float*)(pws(p) + OFF_MOD);
    for (int tile = bidx(); tile < DEPTH * 72; tile += gridDim.x) {
        const int l = tile / 72, ct = tile % 72, hf = lane >> 5, col = ct * 128 + (lane & 31) * 4;
        const float* W = pin(p, I_WADA) + (size_t)l * DM * (NMOD * DM);
        float acc[5][4];
#pragma unroll
        for (int v = 0; v < 5; ++v)
#pragma unroll
            for (int e = 0; e < 4; ++e) acc[v][e] = 0.f;
#pragma unroll 8
        for (int i = 0; i < 64; ++i) { const int k = wid * 128 + 2 * i + hf; const f32x4 w = *(const f32x4*)(W + (size_t)k * (NMOD * DM) + col);
#pragma unroll
            for (int v = 0; v < 5; ++v) { const float sv = s[v * DM + k]; acc[v][0] += sv * w[0]; acc[v][1] += sv * w[1]; acc[v][2] += sv * w[2]; acc[v][3] += sv * w[3]; } }
#pragma unroll
        for (int v = 0; v < 5; ++v) *(f32x4*)(red + ((wid * 2 + hf) * 5 + v) * 128 + (lane & 31) * 4) = (f32x4){acc[v][0], acc[v][1], acc[v][2], acc[v][3]};
        __syncthreads();
        for (int o = tid; o < 640; o += NTHR) { const int v = o >> 7, cc = o & 127; float sum = 0.f;
#pragma unroll
            for (int q = 0; q < 16; ++q) sum += red[(q * 5 + v) * 128 + cc];
            MOD[(size_t)(l * 5 + v) * (NMOD * DM) + ct * 128 + cc] = sum + pin(p, I_BADA)[l * (NMOD * DM) + ct * 128 + cc]; }
        __syncthreads();
    }
    float* TW = (float*)(pws(p) + OFF_TABW); float* TG = (float*)(pws(p) + OFF_TABG);
    const int gt = bidx() * NTHR + tid, GT = gridDim.x * NTHR;
    for (int i = gt; i < SEQ * 96; i += GT) {
        const int t = i / 96, q = i % 96; const bool win = q < 32; const int pr = win ? q : q - 32, nf = win ? 16 : 32;
        const int f = pr % nf; const float pos = (float)(pr < nf ? t / 64 : t % 64);
        const float freq = expf(-(float)f / (float)nf * 9.210340371976184f);
        const float ang = pos * freq; float sn, cs; sincosf(ang, &sn, &cs);
        float* dst = win ? TW + ((size_t)t * 32 + pr) * 2 : TG + ((size_t)t * 64 + pr) * 2; dst[0] = cs; dst[1] = sn;
    }
}

__device__ __forceinline__ void transpose_item(const float* W, int K, int N, int k0, int n0, bf16* WT, int dst_row0, LAS float* scr, int lane) {
    float tv[32];
#pragma unroll
    for (int i = 0; i < 32; ++i) tv[i] = W[(size_t)(k0 + 2 * i + (lane >> 5)) * N + n0 + (lane & 31)];
#pragma unroll
    for (int i = 0; i < 32; ++i) scr[(2 * i + (lane >> 5)) * 33 + (lane & 31)] = tv[i];
    asm volatile("s_waitcnt lgkmcnt(0)" ::: "memory");
    const int c = lane & 7;
#pragma unroll
    for (int j = 0; j < 4; ++j) { const int n = (lane >> 3) + 8 * j; const LAS float* sp = scr + (8 * c) * 33 + n;
        v4u o; o.x = pk2(sp[0 * 33], sp[1 * 33]); o.y = pk2(sp[2 * 33], sp[3 * 33]); o.z = pk2(sp[4 * 33], sp[5 * 33]); o.w = pk2(sp[6 * 33], sp[7 * 33]);
        *(v4u*)(WT + (size_t)(dst_row0 + n) * K + k0 + 8 * c) = o; }
    asm volatile("s_waitcnt lgkmcnt(0)" ::: "memory");
}
__device__ __forceinline__ void phase_convert(const Params& p, int l, LAS unsigned char* lds) {
    const int tid = tidx(), wid = tid >> 6, lane = tid & 63;
    LAS float* scr = (LAS float*)(lds + wid * 16384);
    const int gw = bidx() * NWAVES + wid, NGW = gridDim.x * NWAVES;
    const bool even = (l & 1) == 0; const int li = l >> 1, nin = even ? EVEN_IN : ODD_IN;
    constexpr int I_G = 16 * (FF / 32), I_D = (FF / 64) * 32;
    const int i_in = 16 * (nin / 32), i_out = 16 * 32, i_lru = even ? 64 : 0;
    const int total = 2 * (2 * I_G + I_D) + i_in + i_out + i_lru;
    for (int it = gw; it < total; it += NGW) {
        int r = it;
        if (r < 2 * (2 * I_G + I_D)) {
            const int f = r / (2 * I_G + I_D); r -= f * (2 * I_G + I_D);
            bf16* wgu = (bf16*)(pws(p) + (f ? OFF_WGU1 : OFF_WGU0)); bf16* wd = (bf16*)(pws(p) + (f ? OFF_WD1 : OFF_WD0));
            const size_t wo = (size_t)(l * 2 + f) * DM * FF;
            if (r < 2 * I_G) { const int up = r / I_G; r -= up * I_G; const int kb = r / (FF / 32), nb = r % (FF / 32), n0 = nb * 32;
                transpose_item(pin(p, up ? I_WU : I_WG) + wo, DM, FF, kb * 64, n0, wgu, 256 * (n0 >> 7) + 128 * up + (n0 & 127), scr, lane); }
            else { r -= 2 * I_G; const int kb = r / 32, nb = r % 32; transpose_item(pin(p, I_WDN) + wo, FF, DM, kb * 64, nb * 32, wd, nb * 32, scr, lane); }
            continue;
        }
        r -= 2 * (2 * I_G + I_D);
        if (r < i_in) { const int nbn = nin / 32, kb = r / nbn, nb = r % nbn;
            transpose_item(even ? pin(p, I_EWIN) + (size_t)li * DM * EVEN_IN : pin(p, I_OWIN) + (size_t)li * DM * ODD_IN, DM, nin, kb * 64, nb * 32, (bf16*)(pws(p) + OFF_WIN), nb * 32, scr, lane); continue; }
        r -= i_in;
        if (r < i_out) { const int kb = r / 32, nb = r % 32;
            transpose_item((even ? pin(p, I_EWOUT) : pin(p, I_OWOUT)) + (size_t)li * DM * DM, DM, DM, kb * 64, nb * 32, (bf16*)(pws(p) + OFF_WOUT), nb * 32, scr, lane); continue; }
        r -= i_out;
        {
            const int nb = r & 1, h = (r >> 1) & 7, g = r >> 4, dir = g >> 1, which = g & 1;
            const float* W = pin(p, which ? I_LWX : I_LWA) + ((size_t)(li * 2 + dir) * 8 + h) * 4096;
            transpose_item(W, 64, 64, 0, nb * 32, (bf16*)(pws(p) + OFF_LW) + (size_t)h * 256 * 64, g * 64 + nb * 32, scr, lane); }
    }
}

struct RowCtx { const float* YP; const float* MOD; unsigned short* XH; unsigned char* XL; const bf16* Y; bf16* U; const float* gpost; const float* gpre; int l, s, pl, pk; float coef; bool first, has_next; };
__device__ __forceinline__ RowCtx rowctx(const Params& p, int l, int s) {
    RowCtx c; c.YP = (const float*)(pws(p) + OFF_PB); c.l = l; c.s = s; c.first = (l == 0 && s == 0); c.has_next = l < DEPTH;
    c.pl = s == 0 ? l - 1 : l; c.pk = s == 0 ? 8 : (s == 1 ? 2 : 5); const int pn = s == 0 ? 2 : (s == 1 ? 0 : 1); c.coef = s == 2 ? 1.0f : 0.5f;
    c.MOD = (const float*)(pws(p) + OFF_MOD); c.XH = (unsigned short*)(pws(p) + OFF_X); c.XL = (unsigned char*)(pws(p) + OFF_X + (size_t)MROWS * DM * 2);     c.Y = (const bf16*)(pws(p) + OFF_Y); c.U = (bf16*)(pws(p) + OFF_U);
    c.gpost = c.first ? nullptr : pin(p, I_NPOST) + (size_t)(c.pl * 3 + pn) * DM;
    c.gpre = c.has_next ? pin(p, I_NPRE) + (size_t)(l * 3 + s) * DM : nullptr;
    return c;
}
template <int NR> struct RowRaw { unsigned long long xh[NR][4]; unsigned xl[NR][4]; unsigned long long yw[NR][4]; };
template <int NR> __device__ __forceinline__ void rp_load(const RowCtx& c, const int (&r)[NR], int lane, RowRaw<NR>& w) {
#pragma unroll
    for (int n = 0; n < NR; ++n) { const unsigned short* xh = c.XH + (size_t)r[n] * DM; const unsigned char* xl = c.XL + (size_t)r[n] * DM; const bf16* yr = c.Y + (size_t)r[n] * DM;
#pragma unroll
        for (int j = 0; j < 4; ++j) { w.xh[n][j] = *(const unsigned long long*)(xh + 4 * lane + 256 * j); w.xl[n][j] = *(const unsigned*)(xl + 4 * lane + 256 * j); w.yw[n][j] = *(const unsigned long long*)(yr + 4 * lane + 256 * j); } }
}
#ifndef RP_PREFETCH
#define RP_PREFETCH 0
#endif
struct ModCache { int v; f32x4 ggp[4], gqs[4], sh[4]; };
__device__ __forceinline__ void mc_load(const RowCtx& c, ModCache& mc, int v, int lane) {
    mc.v = v;
    if (!c.first) { const float* gate = c.MOD + ((size_t)(c.pl * 5 + v) * NMOD + c.pk) * DM;
#pragma unroll
        for (int j = 0; j < 4; ++j) mc.ggp[j] = *(const f32x4*)(gate + 4 * lane + 256 * j) * *(const f32x4*)(c.gpost + 4 * lane + 256 * j); }
    if (c.has_next) { const float* sh = c.MOD + ((size_t)(c.l * 5 + v) * NMOD + 3 * c.s) * DM;
#pragma unroll
        for (int j = 0; j < 4; ++j) { mc.sh[j] = *(const f32x4*)(sh + 4 * lane + 256 * j); mc.gqs[j] = *(const f32x4*)(c.gpre + 4 * lane + 256 * j) * (*(const f32x4*)(sh + DM + 4 * lane + 256 * j) + 1.0f); } }
}
template <int NR, bool YPART = false, bool PRE = false>
__device__ __forceinline__ void rowpass_rows(const Params& p, const RowCtx& c, const int (&r)[NR], int lane, ModCache& mc, const RowRaw<NR>* pre = nullptr) {
    int b[NR], rr[NR], v[NR]; bool isc[NR];
    f32x4 x[NR][4]; unsigned long long yw[NR][4];
#pragma unroll
    for (int n = 0; n < NR; ++n) { b[n] = r[n] / SEG; rr[n] = r[n] - b[n] * SEG; isc[n] = rr[n] < LCX; v[n] = isc[n] ? 4 : b[n]; }
    if (c.first) {
#pragma unroll
        for (int n = 0; n < NR; ++n) { const float* src = isc[n] ? pin(p, I_CTX) + ((size_t)b[n] * LCX + rr[n]) * DM : pin(p, I_X) + ((size_t)b[n] * SEQ + (rr[n] - LCX)) * DM;
#pragma unroll
            for (int j = 0; j < 4; ++j) x[n][j] = *(const f32x4*)(src + 4 * lane + 256 * j); }
    } else {
#pragma unroll
        for (int n = 0; n < NR; ++n) { const unsigned short* xh = c.XH + (size_t)r[n] * DM; const unsigned char* xl = c.XL + (size_t)r[n] * DM; const bf16* yr = c.Y + (size_t)r[n] * DM;
#pragma unroll
            for (int j = 0; j < 4; ++j) { { unsigned long long hw; unsigned lw; if constexpr (PRE) { hw = pre->xh[n][j]; lw = pre->xl[n][j]; } else { hw = *(const unsigned long long*)(xh + 4 * lane + 256 * j); lw = *(const unsigned*)(xl + 4 * lane + 256 * j); } const unsigned h0 = (unsigned)hw, h1 = (unsigned)(hw >> 32);
                x[n][j] = (f32x4){__builtin_bit_cast(float, (h0 << 16) | ((lw & 0xffu) << 8)), __builtin_bit_cast(float, (h0 & 0xffff0000u) | (lw & 0xff00u)), __builtin_bit_cast(float, (h1 << 16) | ((lw >> 8) & 0xff00u)), __builtin_bit_cast(float, (h1 & 0xffff0000u) | ((lw >> 16) & 0xff00u))}; }
                if constexpr (PRE) yw[n][j] = pre->yw[n][j]; else if constexpr (!YPART) yw[n][j] = *(const unsigned long long*)(yr + 4 * lane + 256 * j); } }
#pragma unroll
        for (int n = 0; n < NR; ++n) { f32x4 y[4]; float ss = 0.f;
#pragma unroll
            for (int j = 0; j < 4; ++j) { if constexpr (YPART) { const float* y0 = c.YP + (size_t)(b[n] * LCX + rr[n]) * DM + 4 * lane + 256 * j; y[j] = *(const f32x4*)y0 + *(const f32x4*)(y0 + (size_t)NB * LCX * DM); }
                else { const unsigned w0 = (unsigned)yw[n][j], w1 = (unsigned)(yw[n][j] >> 32); y[j] = (f32x4){bflo(w0), bfhi(w0), bflo(w1), bfhi(w1)}; } ss += (y[j][0] * y[j][0] + y[j][1] * y[j][1]) + (y[j][2] * y[j][2] + y[j][3] * y[j][3]); }
            const float rs = rsqrtf(wave_sum(ss) * (1.0f / DM) + EPS) * c.coef;
            if (v[n] != mc.v) mc_load(c, mc, v[n], lane);
#pragma unroll
            for (int j = 0; j < 4; ++j) x[n][j] = x[n][j] + mc.ggp[j] * (y[j] * rs); }
    }
    if (!c.has_next) {
#pragma unroll
        for (int n = 0; n < NR; ++n) if (!isc[n]) { float* o = pout(p) + ((size_t)b[n] * SEQ + (rr[n] - LCX)) * DM;
#pragma unroll
            for (int j = 0; j < 4; ++j) *(f32x4*)(o + 4 * lane + 256 * j) = x[n][j]; }
        return; }
#pragma unroll
    for (int n = 0; n < NR; ++n) { unsigned short* xhw = c.XH + (size_t)r[n] * DM; unsigned char* xlw = c.XL + (size_t)r[n] * DM; float s2 = 0.f;
#pragma unroll
        for (int j = 0; j < 4; ++j) { { unsigned q[4];
#pragma unroll
                for (int e = 0; e < 4; ++e) { const float xe = x[n][j][e]; q[e] = __builtin_bit_cast(unsigned, xe) + 0x80u; }
                *(unsigned long long*)(xhw + 4 * lane + 256 * j) = (unsigned long long)((q[0] >> 16) | (q[1] & 0xffff0000u)) | ((unsigned long long)((q[2] >> 16) | (q[3] & 0xffff0000u)) << 32);
                *(unsigned*)(xlw + 4 * lane + 256 * j) = ((q[0] >> 8) & 0xffu) | (q[1] & 0xff00u) | ((q[2] << 8) & 0xff0000u) | ((q[3] << 16) & 0xff000000u); }
            s2 += (x[n][j][0] * x[n][j][0] + x[n][j][1] * x[n][j][1]) + (x[n][j][2] * x[n][j][2] + x[n][j][3] * x[n][j][3]); }
        const float rx = rsqrtf(wave_sum(s2) * (1.0f / DM) + EPS);
        if (v[n] != mc.v) mc_load(c, mc, v[n], lane);
        bf16* ur = c.U + (size_t)r[n] * DM;
#pragma unroll
        for (int j = 0; j < 4; ++j) { const f32x4 u = (x[n][j] * rx) * mc.gqs[j] + mc.sh[j];
            st8_wt(ur + 4 * lane + 256 * j, (unsigned long long)pk2(u[0], u[1]) | ((unsigned long long)pk2(u[2], u[3]) << 32)); } }
}
__device__ __forceinline__ void phase_rowpass(const Params& p, int l, int s, int rows, int cu0, bool ypart = false, int slo = 0) {
    const int tid = tidx(), wid = tid >> 6, lane = tid & 63, bx = bidx(), G_ = (int)gridDim.x;
    const int ntot = rows == 0 ? MROWS : (rows == 1 ? NB * SEQ : NB * LCX);
    int lo = 0, n = ntot, gw, NGW;
    if (cu0 > 0 && slo > 0) { const int nA = (int)((long long)ntot * (G_ - cu0) * 16 / ((G_ - cu0) * 16 + cu0 * slo)) & ~1;
        if (bx >= cu0) { n = nA; gw = (bx - cu0) * NWAVES + wid; NGW = (G_ - cu0) * NWAVES; } else { lo = nA; gw = bx * NWAVES + wid; NGW = cu0 * NWAVES; } }
    else { if (bx < cu0) return; gw = (bx - cu0) * NWAVES + wid; NGW = (G_ - cu0) * NWAVES; }
    const RowCtx c = rowctx(p, l, s);
    ModCache mc; mc.v = -1;
#define RP_ROW(i) (rows == 0 ? (i) : (rows == 1 ? ((i) & 3) * SEG + LCX + ((i) >> 2) : ((i) >> 8) * SEG + ((i) & (LCX - 1))))
    int i = lo + gw;
    if (ypart) { for (; i < n; i += NGW) { const int rr1[1] = {RP_ROW(i)}; rowpass_rows<1, true>(p, c, rr1, lane, mc); } }
    if (RP_PREFETCH && !c.first) {
        RowRaw<2> cur, nxt;
        if (i + NGW < n) { const int r0[2] = {RP_ROW(i), RP_ROW(i + NGW)}; rp_load<2>(c, r0, lane, cur); }
        for (; i + NGW < n; i += 2 * NGW) { const int rr2[2] = {RP_ROW(i), RP_ROW(i + NGW)};
            const bool more = i + 3 * NGW < n; if (more) { const int rn[2] = {RP_ROW(i + 2 * NGW), RP_ROW(i + 3 * NGW)}; rp_load<2>(c, rn, lane, nxt); }
            rowpass_rows<2, false, true>(p, c, rr2, lane, mc, &cur); if (more) cur = nxt; }
    }
    for (; i + NGW < n; i += 2 * NGW) { const int rr2[2] = {RP_ROW(i), RP_ROW(i + NGW)}; rowpass_rows<2>(p, c, rr2, lane, mc); }
    if (i < n) { const int rr1[1] = {RP_ROW(i)}; rowpass_rows<1>(p, c, rr1, lane, mc); }
#undef RP_ROW
}

__device__ __forceinline__ void rope8(float* v, const float* tab) {
    const f32x4 t0 = *(const f32x4*)tab, t1 = *(const f32x4*)(tab + 4);
    const float c[4] = {t0[0], t0[2], t1[0], t1[2]}, sn[4] = {t0[1], t0[3], t1[1], t1[3]};
#pragma unroll
    for (int i = 0; i < 4; ++i) { const float a = v[2 * i], b = v[2 * i + 1]; v[2 * i] = a * c[i] - b * sn[i]; v[2 * i + 1] = a * sn[i] + b * c[i]; }
}
__device__ __forceinline__ void phase_prep(const Params& p, int l) {
    const int gt = bidx() * NTHR + tidx(), GT = gridDim.x * NTHR;
    bf16* P = (bf16*)(pws(p) + OFF_P);
    constexpr int NU = 4;
    if ((l & 1) == 0) {
        const float* TW = (const float*)(pws(p) + OFF_TABW);
        constexpr int NTOT = NB * SEQ * 16;
        for (int i0 = gt; i0 < NTOT; i0 += NU * GT) {
            bf16* ptr[NU]; v4u w[NU]; const float* tb[NU]; bool ok[NU];
#pragma unroll
            for (int u = 0; u < NU; ++u) { const int i = i0 + u * GT; ok[u] = i < NTOT; const int ii = ok[u] ? i : gt;
                const int rl = ii / 16, ch = ii % 16, b = rl / SEQ, t = rl % SEQ; const size_t row = (size_t)b * SEG + LCX + t;
                ptr[u] = P + row * EVEN_IN + 1536 + ch * 8; w[u] = *(const v4u*)ptr[u]; tb[u] = TW + ((size_t)t * 32 + ((ch * 8) & 63) / 2) * 2; }
#pragma unroll
            for (int u = 0; u < NU; ++u) { float v[8] = {bflo(w[u].x), bfhi(w[u].x), bflo(w[u].y), bfhi(w[u].y), bflo(w[u].z), bfhi(w[u].z), bflo(w[u].w), bfhi(w[u].w)};
                rope8(v, tb[u]);
                v4u o; o.x = pk2(v[0], v[1]); o.y = pk2(v[2], v[3]); o.z = pk2(v[4], v[5]); o.w = pk2(v[6], v[7]); if (ok[u]) *(v4u*)ptr[u] = o; }
        }
    } else {
        const int li = l >> 1; const float* TG = (const float*)(pws(p) + OFF_TABG);
        const int l16 = tidx() & 15; const float* gq = pin(p, I_OQN); const float* gk = pin(p, I_OKN);
        constexpr int NTOT = MROWS * 2 * 16;
        for (int i0 = gt; i0 < NTOT; i0 += NU * GT) {
            bf16* ptr[NU]; v4u w[NU]; bool ok[NU]; int hh[NU], rr[NU];
#pragma unroll
            for (int u = 0; u < NU; ++u) { const int i = i0 + u * GT; ok[u] = i < NTOT; const int ii = ok[u] ? i : gt;
                const int hr = ii >> 4, r = hr >> 1; hh[u] = 8 + (hr & 1); const int b = r / SEG; rr[u] = r - b * SEG;
                ptr[u] = P + (size_t)r * ODD_IN + hh[u] * 128 + l16 * 8; w[u] = *(const v4u*)ptr[u]; }
#pragma unroll
            for (int u = 0; u < NU; ++u) { float v[8] = {bflo(w[u].x), bfhi(w[u].x), bflo(w[u].y), bfhi(w[u].y), bflo(w[u].z), bfhi(w[u].z), bflo(w[u].w), bfhi(w[u].w)};
                float ss = 0.f;
#pragma unroll
                for (int e = 0; e < 8; ++e) ss += v[e] * v[e];
                ss += __shfl_xor(ss, 1); ss += __shfl_xor(ss, 2); ss += __shfl_xor(ss, 4); ss += __shfl_xor(ss, 8);
                const float rs = rsqrtf(ss * (1.0f / 128.0f) + EPS);
                const float* g = (hh[u] < 8 ? gq : gk) + li * 128 + l16 * 8;
#pragma unroll
                for (int e = 0; e < 8; ++e) v[e] = v[e] * rs * g[e];
                if (rr[u] >= LCX) rope8(v, TG + ((size_t)(rr[u] - LCX) * 64 + l16 * 4) * 2);
                v4u o; o.x = pk2(v[0], v[1]); o.y = pk2(v[2], v[3]); o.z = pk2(v[4], v[5]); o.w = pk2(v[6], v[7]); if (ok[u]) *(v4u*)ptr[u] = o; }
        }
    }
}
#define XB_TMO      128
#define XB_XCNT(j)  (256  + 64 * (j))
#define XB_XSUB(j)  (1280 + 64 * (j))
#define XB_XGEN(j)  (2304 + 64 * (j))
#define XB_TOP      3328
#define XB_TOPGEN   3392
#define XCD_BAR_WORDS 3456
#define XB_SPIN_CAP (1u << 18)

__device__ __forceinline__ unsigned xb_ld(unsigned* p)              { return __hip_atomic_load(p, __ATOMIC_RELAXED, __HIP_MEMORY_SCOPE_AGENT); }
__device__ __forceinline__ unsigned xb_add(unsigned* p, unsigned v) { return __hip_atomic_fetch_add(p, v, __ATOMIC_RELAXED, __HIP_MEMORY_SCOPE_AGENT); }
__device__ __forceinline__ unsigned xb_xcc_id() { return (unsigned)__builtin_amdgcn_s_getreg((3 << 11) | 20) & 0xFu; }
#define XB_SPIN(cond, bar) do { unsigned _sp = 0; while (cond) { __builtin_amdgcn_s_sleep(1); \
    if ((++_sp & 255u) == 0u) { if (xb_ld(&(bar)[XB_TMO])) break; if (_sp > XB_SPIN_CAP) { atomicAdd(&(bar)[XB_TMO], 1u); break; } } } } while (0)

struct XcdBarrier {
    unsigned* bar; unsigned x;
    volatile LAS unsigned* st;
};

__device__ __forceinline__ XcdBarrier xcd_barrier_post(unsigned* bar, volatile LAS unsigned* st) {
    XcdBarrier b; b.bar = bar; b.x = xb_xcc_id(); b.st = st;
    if (threadIdx.x == 0) (void)xb_add(&bar[XB_XCNT(b.x)], 1u);
    return b;
}
__device__ __forceinline__ void xcd_barrier_complete(unsigned* bar, unsigned x, unsigned& nloc, unsigned& nx) {
    const unsigned G = gridDim.x * gridDim.y * gridDim.z;
    unsigned sum, cnt, mine, sp = 0u;
    for (;;) {
        sum = 0u; cnt = 0u; mine = 0u;
#pragma unroll
        for (unsigned j = 0; j < 16; ++j) { const unsigned c = xb_ld(&bar[XB_XCNT(j)]); sum += c; cnt += (c > 0u) ? 1u : 0u; mine = (j == x) ? c : mine; }
        if (sum == G) break;
        __builtin_amdgcn_s_sleep(1);
        if ((++sp & 255u) == 0u) { if (xb_ld(&bar[XB_TMO])) break; if (sp > XB_SPIN_CAP) { atomicAdd(&bar[XB_TMO], 1u); break; } }
    }
    nloc = mine > 0u ? mine : 1u; nx = cnt > 0u ? cnt : 1u;
}

__device__ __forceinline__ void xcd_barrier(const XcdBarrier& b) {
    asm volatile("s_waitcnt vmcnt(0)" ::: "memory");
    __syncthreads();
    if (threadIdx.x == 0) {
        unsigned* bar = b.bar;
        __builtin_amdgcn_s_waitcnt(0);
        unsigned nloc = b.st[0], nx = b.st[1];
        if (nloc == 0u) { xcd_barrier_complete(bar, b.x, nloc, nx); b.st[0] = nloc; b.st[1] = nx; }
        const unsigned old = xb_add(&bar[XB_XSUB(b.x)], 1u);
        const unsigned gen = old / nloc;
        if (old + 1u == (gen + 1u) * nloc) {
            __builtin_amdgcn_fence(__ATOMIC_RELEASE, "agent");
            asm volatile("s_waitcnt vmcnt(0)" ::: "memory");
            const unsigned og = xb_add(&bar[XB_TOP], 1u);
            const unsigned tg = og / nx;
            if (og + 1u == (tg + 1u) * nx) xb_add(&bar[XB_TOPGEN], 1u);
            else XB_SPIN(xb_ld(&bar[XB_TOPGEN]) == tg, bar);
            __builtin_amdgcn_fence(__ATOMIC_ACQUIRE, "agent");
            xb_add(&bar[XB_XGEN(b.x)], 1u);
            asm volatile("s_waitcnt vmcnt(0)" ::: "memory");
        } else {
            XB_SPIN(xb_ld(&bar[XB_XGEN(b.x)]) == gen, bar);
            __builtin_amdgcn_fence(__ATOMIC_ACQUIRE, "agent");
            asm volatile("s_waitcnt vmcnt(0)" ::: "memory");
        }
    }
    __syncthreads();
}
__device__ __forceinline__ float fast_sigmoid(float x) { return __builtin_amdgcn_rcpf(1.0f + __builtin_amdgcn_exp2f(-1.4426950408889634f * x)); }
__device__ __forceinline__ float gelu_tanh(float x) { const float u = 0.7978845608028654f * (x + 0.044715f * x * x * x); const float th = 1.0f - 2.0f * __builtin_amdgcn_rcpf(1.0f + __builtin_amdgcn_exp2f(2.8853900817779268f * u)); return 0.5f * x * (1.0f + th); }
template <bool FINAL>
__device__ __forceinline__ void phase_lru(const Params& p, int l, char* lds) {
    typedef float f32x4_ __attribute__((ext_vector_type(4)));
    const int tid = tidx(), wid = tid >> 6, lane = tid & 63, li = l >> 1, bx = bidx(), G_ = (int)gridDim.x;
    float* xs = (float*)lds;
    float* xcf = (float*)(lds + 17408);
    bf16* xcb = (bf16*)(lds + 17408 + 16384);
    bf16* lw = (bf16*)(lds + 17408 + 16384 + 9216);
    float* G = (float*)(lds + 17408 + 16384 + 9216 + 36864);
    float* SEGA = (float*)(lds + 145408);
    float* SEGB = SEGA + 512;
    const bf16* P = (const bf16*)(pws(p) + OFF_P); bf16* Z = (bf16*)(pws(p) + OFF_Z);
    float* CHA = (float*)(pws(p) + OFF_CHA); float* CHB = (float*)(pws(p) + OFF_CHB); const float* CAR = (const float*)(pws(p) + OFF_CAR);
    const bool fixed_h = (G_ & 7) == 0; int h_loaded = -1;
    float cw0 = 0.f, cw1 = 0.f, cw2 = 0.f, cw3 = 0.f, cwb = 0.f, kba[2] = {0.f, 0.f}, kbx[2] = {0.f, 0.f}, ksp[2] = {0.f, 0.f};
    v4u pre0 = (v4u){0u, 0u, 0u, 0u}, pre1 = (v4u){0u, 0u, 0u, 0u};
#define LRU_HALO_LOAD(TILE) do { const int h_ = (TILE) & 7, ck_ = ((TILE) >> 3) % NCHUNK, b_ = ((TILE) >> 3) / NCHUNK, lo_ = ck_ < 4 ? 0 : LCX, hi_ = ck_ < 4 ? LCX : SEG; \
        { const int hr = tid >> 3, c8 = (tid & 7) * 8, rr = ck_ * 64 - 2 + hr; pre0 = (rr >= lo_ && rr < hi_) ? *(const v4u*)(P + ((size_t)b_ * SEG + rr) * EVEN_IN + h_ * 64 + c8) : (v4u){0u, 0u, 0u, 0u}; } \
        if (tid < 24) { const int hr = 64 + (tid >> 3), c8 = (tid & 7) * 8, rr = ck_ * 64 - 2 + hr; pre1 = (rr >= lo_ && rr < hi_) ? *(const v4u*)(P + ((size_t)b_ * SEG + rr) * EVEN_IN + h_ * 64 + c8) : (v4u){0u, 0u, 0u, 0u}; } } while (0)
#define LRU_HALO_PUT(W, C) do { const int hr = (C) >> 3, c8 = ((C) & 7) * 8; \
        *(f32x4_*)(xs + hr * 64 + c8) = (f32x4_){bflo((W).x), bfhi((W).x), bflo((W).y), bfhi((W).y)}; *(f32x4_*)(xs + hr * 64 + c8 + 4) = (f32x4_){bflo((W).z), bfhi((W).z), bflo((W).w), bfhi((W).w)}; } while (0)
    if (bx < NB * NCHUNK * 8) LRU_HALO_LOAD(bx);
    for (int tile = bx; tile < NB * NCHUNK * 8; tile += G_) {
        const int h = tile & 7, ck = (tile >> 3) % NCHUNK, b = (tile >> 3) / NCHUNK;
        const int seg_lo = ck < 4 ? 0 : LCX, seg_hi = ck < 4 ? LCX : SEG, t0 = ck * 64;
        const size_t rbase = (size_t)b * SEG;
        LRU_HALO_PUT(pre0, tid); if (tid < 24) LRU_HALO_PUT(pre1, tid + 512);
        v4u gaw = (v4u){0u, 0u, 0u, 0u}; float carry_in = 0.f;
        if (FINAL) { gaw = *(const v4u*)(P + (rbase + t0 + (tid >> 3)) * EVEN_IN + LRUW + h * 64 + (tid & 7) * 8);
            if (tid < 128) carry_in = CAR[(((size_t)(tid >> 6) * NB + b) * NCHUNK + ck) * LRUW + h * 64 + (tid & 63)]; }
        if (!fixed_h || h_loaded != h) { const bf16* LW = (const bf16*)(pws(p) + OFF_LW) + (size_t)h * 256 * 64; h_loaded = h;
          { const int ch = tid & 63; const float* cw = pin(p, I_ECW) + (size_t)li * 4 * LRUW + h * 64 + ch; cw0 = cw[0]; cw1 = cw[LRUW]; cw2 = cw[2 * LRUW]; cw3 = cw[3 * LRUW]; cwb = pin(p, I_ECB)[li * LRUW + h * 64 + ch];
#pragma unroll
            for (int dir = 0; dir < 2; ++dir) { const int cidx = (li * 2 + dir) * LRUW + h * 64 + ch; kba[dir] = pin(p, I_LBA)[cidx]; kbx[dir] = pin(p, I_LBX)[cidx]; ksp[dir] = -8.0f * log1pf(expf(-pin(p, I_LAM)[cidx])); } }
#pragma unroll
          for (int q = 0; q < 4; ++q) { const int c = tid + q * NTHR, n = c >> 3, c8 = (c & 7) * 8; *(v4u*)(lw + n * 72 + c8) = *(const v4u*)(LW + n * 64 + c8); } }
        __syncthreads();
        { const int ch = tid & 63, tb = (tid >> 6) * 8; float xv[11], cv[8];
#pragma unroll
          for (int i = 0; i < 11; ++i) xv[i] = xs[(tb + i) * 64 + ch];
#pragma unroll
          for (int i = 0; i < 8; ++i) cv[i] = cwb + cw0 * xv[i] + cw1 * xv[i + 1] + cw2 * xv[i + 2] + cw3 * xv[i + 3];
#pragma unroll
          for (int i = 0; i < 8; ++i) { xcf[(tb + i) * 64 + ch] = cv[i]; xcb[(tb + i) * 72 + ch] = (bf16)f2bf(cv[i]); } }
        __syncthreads();
        if (tile + G_ < NB * NCHUNK * 8) LRU_HALO_LOAD(tile + G_);
        { const int fr = lane & 15, fq = lane >> 4;
          f32x4_ acc[4][2];
#pragma unroll
          for (int m = 0; m < 4; ++m)
#pragma unroll
              for (int n = 0; n < 2; ++n) acc[m][n] = (f32x4_){0.f, 0.f, 0.f, 0.f};
#pragma unroll
          for (int k = 0; k < 2; ++k) { bf16x8 af[4], bfr[2];
#pragma unroll
              for (int m = 0; m < 4; ++m) af[m] = *(const bf16x8*)(xcb + (m * 16 + fr) * 72 + k * 32 + fq * 8);
#pragma unroll
              for (int n = 0; n < 2; ++n) bfr[n] = *(const bf16x8*)(lw + (wid * 32 + n * 16 + fr) * 72 + k * 32 + fq * 8);
#pragma unroll
              for (int m = 0; m < 4; ++m)
#pragma unroll
                  for (int n = 0; n < 2; ++n) acc[m][n] = __builtin_amdgcn_mfma_f32_16x16x32_bf16(af[m], bfr[n], acc[m][n], 0, 0, 0); }
#pragma unroll
          for (int m = 0; m < 4; ++m)
#pragma unroll
              for (int n = 0; n < 2; ++n) { const int ncol = wid * 32 + n * 16 + fr, g = ncol >> 6, j = ncol & 63;
#pragma unroll
                  for (int e = 0; e < 4; ++e) G[(g * 64 + m * 16 + fq * 4 + e) * 64 + j] = acc[m][n][e]; } }
        __syncthreads();
        { const int ch = tid & 63, tb = (tid >> 6) * 8; float xc8[8];
#pragma unroll
          for (int i = 0; i < 8; ++i) xc8[i] = xcf[(tb + i) * 64 + ch];
#pragma unroll
          for (int dir = 0; dir < 2; ++dir) { const float ba = kba[dir], bxx = kbx[dir], sp8 = ksp[dir]; float gav[8], gxv[8];
              float* ga = G + ((2 * dir) * 64 + tb) * 64 + ch; float* gx = G + ((2 * dir + 1) * 64 + tb) * 64 + ch;
#pragma unroll
              for (int i = 0; i < 8; ++i) { gav[i] = ga[i * 64]; gxv[i] = gx[i * 64]; }
#pragma unroll
              for (int i = 0; i < 8; ++i) {
                  const float ea = __builtin_amdgcn_exp2f(fminf(-1.4426950408889634f * (gav[i] + ba), 60.0f)), eb = __builtin_amdgcn_exp2f(fminf(-1.4426950408889634f * (gxv[i] + bxx), 60.0f));
                  const float A1 = 1.0f + ea, B1 = 1.0f + eb, rab = __builtin_amdgcn_rcpf(A1 * B1), r = B1 * rab, ig = A1 * rab, la = r * sp8, z = 2.0f * la;
                  float av = 1.0f + la * (1.0f + la * (0.5f + la * (0.16666667f + la * (0.041666668f + la * 0.0083333338f))));
                  float om = -z * (1.0f + z * (0.5f + z * (0.16666667f + z * (0.041666668f + z * (0.0083333338f + z * 0.0013888889f)))));
                  if (__builtin_expect(__any(la < -0.25f), 0)) { if (la < -0.25f) { av = __builtin_amdgcn_exp2f(1.4426950408889634f * la); om = 1.0f - __builtin_amdgcn_exp2f(1.4426950408889634f * z); } }
                  gav[i] = av; gxv[i] = __builtin_amdgcn_sqrtf(om) * ig * xc8[i]; }
#pragma unroll
              for (int i = 0; i < 8; ++i) { ga[i * 64] = gav[i]; gx[i * 64] = gxv[i]; } } }
        __syncthreads();
        { const int sg = tid >> 7, dc = tid & 127, dir = dc >> 6, ch = dc & 63;
          float* ga = G + (2 * dir) * 4096 + ch; float* gb = G + (2 * dir + 1) * 4096 + ch;
          float hs = 0.f, ap = 1.f, av[16], bv[16];
          const int tq0 = dir ? 63 - sg * 16 : sg * 16, tst = dir ? -64 : 64;
          float* gaq = ga + tq0 * 64; float* gbq = gb + tq0 * 64;
#pragma unroll
          for (int i = 0; i < 16; ++i) { av[i] = gaq[i * tst]; bv[i] = gbq[i * tst]; }
#pragma unroll
          for (int i = 0; i < 16; ++i) { hs = av[i] * hs + bv[i]; ap *= av[i]; av[i] = ap; bv[i] = hs; }
          if (FINAL) {
#pragma unroll
              for (int i = 0; i < 16; ++i) { gaq[i * tst] = av[i]; gbq[i * tst] = bv[i]; } }
          SEGA[sg * 128 + dc] = ap; SEGB[sg * 128 + dc] = hs; }
        __syncthreads();
        if (tid < 128) { const int dir = tid >> 6, ch = tid & 63; const size_t sidx = (((size_t)dir * NB + b) * NCHUNK + ck) * LRUW + h * 64 + ch;
            float hin = carry_in, apt = 1.f;
#pragma unroll
            for (int sg = 0; sg < 4; ++sg) { const float a = SEGA[sg * 128 + tid], bb = SEGB[sg * 128 + tid]; if (FINAL) SEGA[sg * 128 + tid] = hin; hin = a * hin + bb; apt *= a; }
            if (!FINAL) { CHA[sidx] = apt; CHB[sidx] = hin; } }
        if (FINAL) { __syncthreads();
            { const int t = tid >> 3, c8 = (tid & 7) * 8; const size_t row = rbase + t0 + t;
              const v4u w = gaw;
              const float gv[8] = {bflo(w.x), bfhi(w.x), bflo(w.y), bfhi(w.y), bflo(w.z), bfhi(w.z), bflo(w.w), bfhi(w.w)};
              const int sf = t >> 4, sb = (63 - t) >> 4;
              float o[8];
#pragma unroll
              for (int e = 0; e < 8; ++e) { const int c = c8 + e;
                  const float hf = G[(64 + t) * 64 + c] + G[t * 64 + c] * SEGA[sf * 128 + c], hb = G[(192 + t) * 64 + c] + G[(128 + t) * 64 + c] * SEGA[sb * 128 + 64 + c];
                  o[e] = (hf + hb) * gelu_tanh(gv[e]); }
              v4u ov; ov.x = pk2(o[0], o[1]); ov.y = pk2(o[2], o[3]); ov.z = pk2(o[4], o[5]); ov.w = pk2(o[6], o[7]);
              *(v4u*)(Z + row * DM + h * 64 + c8) = ov; } }
        __syncthreads();
    }
#undef LRU_HALO_LOAD
#undef LRU_HALO_PUT
}
__device__ __forceinline__ void phase_lru_carry(const Params& p) {
    const float* CHA = (const float*)(pws(p) + OFF_CHA); const float* CHB = (const float*)(pws(p) + OFF_CHB); float* CAR = (float*)(pws(p) + OFF_CAR);
    const int nb = 2 * NB * LRUW / NTHR, first = (int)gridDim.x >= nb ? (int)gridDim.x - nb : 0;
    const int bx = bidx(); if (bx < first) return;
    for (int g = (bx - first) * NTHR + tidx(); g < 2 * NB * LRUW; g += ((int)gridDim.x - first) * NTHR) {
        const int c = g % LRUW, b = (g / LRUW) % NB, dir = g / (LRUW * NB);
        const size_t base = ((size_t)dir * NB + b) * NCHUNK * LRUW + c;
        float hs = 0.f;
        for (int s0 = 0; s0 < NCHUNK; s0 += 22) {
            float av[22], bv[22]; int ck[22];
#pragma unroll
            for (int j = 0; j < 22; ++j) { const int s = s0 + j; ck[j] = dir == 0 ? s : (s < 4 ? 3 - s : NCHUNK - 1 - (s - 4)); av[j] = CHA[base + (size_t)ck[j] * LRUW]; bv[j] = CHB[base + (size_t)ck[j] * LRUW]; }
#pragma unroll
            for (int j = 0; j < 22; ++j) { CAR[base + (size_t)ck[j] * LRUW] = hs; hs = av[j] * hs + bv[j]; }
        }
    }
}

__device__ __forceinline__ void phase_attn(const Params& p, int l, char* lds) {
    const bf16* P = (const bf16*)(pws(p) + OFF_P); bf16* Z = (bf16*)(pws(p) + OFF_Z);
    const bool even = (l & 1) == 0, with_ctx = l < DEPTH - 1; const int li = l >> 1;
    const int nunits = 1024 + (with_ctx ? 32 : 0);
    for (int idx = bidx(); idx < nunits; idx += gridDim.x) {
        if (idx < 1024) {
            const int g = idx & 7, local = idx >> 3, b = g >> 1, kv = g & 1, h = kv * 4 + (local >> 5), qb = local & 31, q0 = qb * 256;
            const size_t kbase = (size_t)b * SEG, qrow = kbase + LCX + q0;
            if (even) {
                const int pair = local >> 6, qb2 = local & 63, q0w = qb2 * 128, h0 = kv * 4 + pair * 2; const size_t qrow2 = kbase + LCX + q0w;
                const int band0 = q0w - 128 < 0 ? 0 : q0w - 128, bend = q0w + 256 > SEQ ? SEQ : q0w + 256, NT = 4 + (bend - band0) / 64;
                att::attn_body<64, EVEN_IN, EVEN_IN, DM, 128, true, 1, 128>(P + qrow2 * EVEN_IN + 1024 + h0 * 64, P + kbase * EVEN_IN + 1536 + kv * 64,
                    Z + qrow2 * DM + 512 + h0 * 64, NT, band0, q0w, pin(p, I_SINK)[li * 8 + h0] * 1.4426950408889634f, nullptr, (const float*)(pws(p) + OFF_TABW) + (size_t)q0w * 64, lds, pin(p, I_SINK)[li * 8 + h0 + 1] * 1.4426950408889634f);
            } else {
                att::attn_body<128, ODD_IN, ODD_IN, DM, 256, false, 3>(P + qrow * ODD_IN + h * 128, P + kbase * ODD_IN + 1024 + kv * 128,
                    Z + qrow * DM + h * 128, SEG / 64, 0, q0, -INFINITY, pin(p, I_OQN) + li * 128, (const float*)(pws(p) + OFF_TABG) + (size_t)q0 * 128, lds);
            }
        } else {
            const int u = idx - 1024, b = u >> 3, h = u & 7, kv = h >> 2; const size_t kbase = (size_t)b * SEG;
            if (even) att::attn_body<64, EVEN_IN, EVEN_IN, DM, 128, false, 0>(P + kbase * EVEN_IN + 1024 + h * 64, P + kbase * EVEN_IN + 1536 + kv * 64,
                    Z + kbase * DM + 512 + h * 64, 4, 0, 0, pin(p, I_SINK)[li * 8 + h] * 1.4426950408889634f, nullptr, nullptr, lds);
            else att::attn_body<128, ODD_IN, ODD_IN, DM, 256, false, 2>(P + kbase * ODD_IN + h * 128, P + kbase * ODD_IN + 1024 + kv * 128,
                    Z + kbase * DM + h * 128, 4, 0, 0, -INFINITY, pin(p, I_OQN) + li * 128, nullptr, lds);
        }
    }
}

constexpr int PPL = 15, NPHASE = 1 + DEPTH * PPL;
constexpr int MISC_OFF = LDS_BYTES - 64;
__device__ __forceinline__ bool phase_exists(int ph) {
    if (ph == 0) return true; const int l = (ph - 1) / PPL, k = (ph - 1) % PPL;
    if (k == 8 && (l & 1)) return false; if (k == 11 && l == DEPTH - 1) return false; return true;
}
__global__ void __launch_bounds__(NTHR, 2) fwd_kernel(Params p) {
    extern __shared__ __attribute__((aligned(16))) unsigned char lds_raw[];
    char* lds = (char*)lds_raw; LAS unsigned char* ldsl = (LAS unsigned char*)lds_raw;
    volatile LAS unsigned* MISC = (volatile LAS unsigned*)(ldsl + MISC_OFF);
    cg::grid_group grid = cg::this_grid();
    if (threadIdx.x < 16) MISC[threadIdx.x] = 0u;
    __syncthreads();
    XcdBarrier bar = xcd_barrier_post((unsigned*)(p.ws + OFF_CTL) + CW_BAR, MISC);
    for (int ph = p.lo, rep = 0; ph < p.hi;) {
        int nrep = 1;
        asm volatile("" : "+s"(ph));
        const bool did = phase_exists(ph);
        if (ph == 0) { for (int r_ = 0; r_ < p.rep_misc; ++r_) phase_mod(p, lds); __syncthreads(); phase_convert(p, 0, ldsl); }
        else if (did) {
            const int l = (ph - 1) / PPL, k = (ph - 1) % PPL; const bool even = (l & 1) == 0, lastl = l == DEPTH - 1;
            nrep = (k == 1 || k == 2 || k == 5 || k == 9 || k == 12 || k == 13) ? p.rep_gemm : (k == 7 ? p.rep_att : 1);
            bf16* U = (bf16*)(pws(p) + OFF_U); bf16* A = (bf16*)(pws(p) + OFF_A); bf16* Pb = (bf16*)(pws(p) + OFF_P); bf16* Z = (bf16*)(pws(p) + OFF_Z); bf16* Y = (bf16*)(pws(p) + OFF_Y);
            const int G = (int)gridDim.x;
            switch (k) {
            case 0: if (l != 0) for (int r_ = 0; r_ < p.rep_misc; ++r_) { phase_convert(p, l, ldsl); __syncthreads(); } phase_rowpass(p, l, 0, l == 0 ? 0 : 2, 0, CTX_KSPLIT && l != 0); break;
            case 1: case 12: { pg8::Gemm g{U, (const bf16*)(pws(p) + (k == 1 ? OFF_WGU0 : OFF_WGU1)), MROWS, NGU, DM}; pg8::OrderX S; S.init(MROWS, NGU, G, bidx(), lastl && k == 12);
                pg8::EpiSwiglu E{A, FF}; pg8::gemm_phase<pg8::EpiSwiglu, pg8::OrderX, true, true>(ldsl, g, S, E); } break;
            case 2: case 9: case 13: { pg8::Gemm g{k == 9 ? Z : A, (const bf16*)(pws(p) + (k == 2 ? OFF_WD0 : (k == 9 ? OFF_WOUT : OFF_WD1))), MROWS, DM, k == 9 ? DM : FF}; pg8::OrderX S; S.init(MROWS, DM, G, bidx(), true);
                pg8::EpiBf16 E{Y, DM}; pg8::gemm_phase<pg8::EpiBf16, pg8::OrderX, true, true>(ldsl, g, S, E); } break;
            case 3: case 10: case 14: { const bool ctx = !(lastl && k != 3);
                int ncu = 0;
                if (ctx && (k == 10 || !CTX_KSPLIT)) { ncu = 16; pg8::Gemm g{k == 10 ? Z : A, (const bf16*)(pws(p) + (k == 3 ? OFF_WD0 : (k == 10 ? OFF_WOUT : OFF_WD1))), MROWS, DM, k == 10 ? DM : FF, 0}; pg8::OrderCtx S{bidx()};
                    pg8::EpiBf16 E{Y, DM}; pg8::gemm_phase<pg8::EpiBf16, pg8::OrderCtx, true, true>(ldsl, g, S, E); }
                else if (ctx) { ncu = 32; const int c = bidx(), kh = c & 1, j = (c >> 3) & 3;
                    pg8::Gemm g{A + (size_t)32 * j * 256 * FF + kh * (FF / 2), (const bf16*)(pws(p) + (k == 3 ? OFF_WD0 : OFF_WD1)) + kh * (FF / 2), NB * LCX, DM, FF / 2, FF}; pg8::OrderCtx2 S{c};
                    pg8::EpiF32 E{(float*)(pws(p) + OFF_PB) + (size_t)kh * NB * LCX * DM, DM}; pg8::gemm_phase<pg8::EpiF32, pg8::OrderCtx2, true, true>(ldsl, g, S, E); }
                phase_rowpass(p, k == 14 ? l + 1 : l, k == 3 ? 1 : (k == 10 ? 2 : 0), 1, G > ncu ? ncu : 0, false, ncu == 32 ? CTX_SHARE32 : (ncu == 16 ? CTX_SHARE16 : 0)); } break;
            case 4: phase_rowpass(p, l, 1, 2, 0, CTX_KSPLIT != 0); break;
            case 11: phase_rowpass(p, l, 2, 2, 0); break;
            case 5: { const int nin = even ? EVEN_IN : ODD_IN; pg8::Gemm g{U, (const bf16*)(pws(p) + OFF_WIN), MROWS, nin, DM}; pg8::OrderX S; S.init(MROWS, nin, G, bidx(), false);
                pg8::EpiBf16 E{Pb, nin}; pg8::gemm_phase<pg8::EpiBf16, pg8::OrderX, true, true>(ldsl, g, S, E); } break;
            case 6: if (even) for (int r_ = 0; r_ < p.rep_lru; ++r_) phase_lru<false>(p, l, lds); phase_prep(p, l); break;
            case 7: if (even) phase_lru_carry(p); phase_attn(p, l, lds); break;
            case 8: for (int r_ = 0; r_ < p.rep_lru; ++r_) phase_lru<true>(p, l, lds); break;
            default: break;
            }
        }
        bool more = rep + 1 < nrep;
        for (int q = ph + 1; !more && q < p.hi; ++q) more = phase_exists(q);
        if (did && more) { if (p.hi < 0) grid.sync(); else for (int r_ = 0; r_ < p.rep_bar; ++r_) xcd_barrier(bar); }
        if (rep + 1 < nrep) ++rep; else { rep = 0; ++ph; }
    }
}

extern "C" void kernel_launch(void* const* d_in, const int* in_sizes, int n_in, void* d_out, int out_size, void* d_ws, size_t ws_size, hipStream_t stream) {
    static int grid = 0;
    if (grid == 0) {
        if (n_in != 25 || out_size != NB * SEQ * DM || ws_size < WS_NEED) { fprintf(stderr, "kernel_launch: unexpected shapes (n_in %d out %d ws %zu, need ws >= %zu)\n", n_in, out_size, ws_size, (size_t)WS_NEED); grid = -1; return; }
        int dev = 0, cus = 0, per_cu = 0;
        hipGetDevice(&dev); hipDeviceGetAttribute(&cus, hipDeviceAttributeMultiprocessorCount, dev);
        if (hipFuncSetAttribute((const void*)fwd_kernel, hipFuncAttributeMaxDynamicSharedMemorySize, LDS_BYTES) != hipSuccess) { fprintf(stderr, "kernel_launch: hipFuncSetAttribute failed\n"); grid = -1; return; }
        if (hipOccupancyMaxActiveBlocksPerMultiprocessor(&per_cu, (const void*)fwd_kernel, NTHR, LDS_BYTES) != hipSuccess || per_cu < 1) { fprintf(stderr, "kernel_launch: occupancy query says %d\n", per_cu); per_cu = 1; }
        (void)hipGetLastError();
        grid = cus * per_cu;
        fprintf(stderr, "kernel_launch: grid %d (cus %d x %d)\n", grid, cus, per_cu);
    }
    if (grid < 0) return;
    if (hipMemsetAsync((char*)d_ws + OFF_CTL, 0, CTL_BYTES, stream) != hipSuccess) { fprintf(stderr, "kernel_launch: memset of the control words failed\n"); return; }
    Params p{};
    for (int i = 0; i < 25; ++i) p.in[i] = (const float*)d_in[i];
    p.out = (float*)d_out; p.ws = (unsigned char*)d_ws; p.rep_gemm = REP_GEMM; p.rep_att = REP_ATT; p.rep_lru = REP_LRU; p.rep_misc = REP_MISC; p.rep_bar = REP_BAR;
#if MK_SINGLE
    p.lo = 0; p.hi = NPHASE;
    void* args[] = {&p};
    hipError_t e = hipLaunchCooperativeKernel((const void*)fwd_kernel, dim3(grid), dim3(NTHR), args, LDS_BYTES, stream);
    if (e != hipSuccess) fprintf(stderr, "cooperative launch failed: %s (grid %d)\n", hipGetErrorString(e), grid);
#else
    for (int ph = 0; ph < NPHASE; ++ph) {
        if (ph >= 1) { const int k = (ph - 1) % PPL, l = (ph - 1) / PPL; if ((k == 8 && (l & 1)) || (k == 11 && l == DEPTH - 1)) continue; }
        p.lo = ph; p.hi = ph + 1;
        hipLaunchKernelGGL(fwd_kernel, dim3(grid), dim3(NTHR), LDS_BYTES, stream, p);
    }
#endif
}
```

```cpp
#include <hip/hip_runtime.h>
#include <hip/hip_cooperative_groups.h>
#include <cstdio>
#include <cstdint>
namespace cg = cooperative_groups;

#ifndef MK_SINGLE
#define MK_SINGLE 1
#endif

#ifndef FUSE_ROWPASS
#define FUSE_ROWPASS 0
#endif
#ifndef CTX_KSPLIT
#define CTX_KSPLIT 1
#endif
#ifndef CTX_SHARE32
#define CTX_SHARE32 0
#endif
#ifndef CTX_SHARE16
#define CTX_SHARE16 0
#endif
#ifndef REP_GEMM
#define REP_GEMM 1
#endif
#ifndef REP_LRU
#define REP_LRU 1
#endif
#ifndef REP_MISC
#define REP_MISC 1
#endif
#ifndef REP_BAR
#define REP_BAR 1
#endif
#ifndef REP_ATT
#define REP_ATT 1
#endif
constexpr int DM = 1024, NB = 4, SEQ = 8192, LCX = 256, SEG = SEQ + LCX  , MROWS = NB * SEG  ;
constexpr int FF = 2816, NGU = 2 * FF, DEPTH = 4, NMOD = 9;
constexpr int EVEN_IN = 1792, ODD_IN = 1536, LRUW = 512;
constexpr float EPS = 1e-6f;
constexpr int NCHUNK = SEG / 64;

__device__ __forceinline__ int tidx() { int t = threadIdx.x; asm volatile("" : "+v"(t)); return t; }
__device__ __forceinline__ int bidx() { int b = blockIdx.x; asm volatile("" : "+s"(b)); return b; }

typedef unsigned wt_u32x4 __attribute__((ext_vector_type(4)));
typedef float wt_f32x4 __attribute__((ext_vector_type(4)));
#ifndef WT_STORES
#define WT_STORES 0
#endif
__device__ __forceinline__ void st16_wt(void* ptr, wt_u32x4 v) {
#if WT_STORES
    asm volatile("global_store_dwordx4 %0, %1, off sc1\n\ts_nop 1" :: "v"(ptr), "v"(v) : "memory");
#else
    *(wt_u32x4*)ptr = v;
#endif
}
__device__ __forceinline__ void st16f_wt(void* ptr, wt_f32x4 v) {
#if WT_STORES
    asm volatile("global_store_dwordx4 %0, %1, off sc1\n\ts_nop 1" :: "v"(ptr), "v"(v) : "memory");
#else
    *(wt_f32x4*)ptr = v;
#endif
}
__device__ __forceinline__ void st8_wt(void* ptr, unsigned long long v) {
#if WT_STORES
    asm volatile("global_store_dwordx2 %0, %1, off sc1\n\ts_nop 1" :: "v"(ptr), "v"(v) : "memory");
#else
    *(unsigned long long*)ptr = v;
#endif
}

namespace pg8 {
#define PG8_LAS __attribute__((address_space(3)))
typedef unsigned short bf16_t;
typedef short bf16x8 __attribute__((ext_vector_type(8)));
typedef float f32x4 __attribute__((ext_vector_type(4)));
typedef unsigned u32x4 __attribute__((ext_vector_type(4)));
constexpr int BM = 256, BK = 64, HALF = 128, HTB = HALF * BK * 2  , STAGE_BYTES = 8 * HTB, NXCD = 8, WGM = 8;

__host__ __device__ __forceinline__ int lds_byte(int r, int c) { const int st = (r >> 4) * 2 + (c >> 5), rr = r & 15, cc = c & 31, ob = rr * 64 + cc * 2; return st * 1024 + (ob ^ (((ob >> 9) & 1) << 5)); }
__host__ __device__ __forceinline__ void stage_rc(int b, int& R, int& C) { const int st = b / 1024, sb = b % 1024, swz = sb ^ (((sb >> 9) & 1) << 5); R = (st >> 1) * 16 + swz / 64; C = (st & 1) * 32 + (swz % 64) / 2; }
__host__ __device__ __forceinline__ int perm32(int rho) { const int n = rho >> 4, i = rho & 15; return 8 * (i >> 2) + 4 * n + (i & 3); }

struct Unit { int pm, pn; };
struct Gemm { const bf16_t* A; const bf16_t* Bt; int M, N, K, ld; };

struct StaticOrder {
    int nM, nN, nwg, G, c;
    __host__ __device__ void init(int M, int N, int G_, int c_) { nM = M / BM; nN = N / BM; nwg = nM * nN; G = G_; c = c_; }
    __host__ __device__ bool next(int i, Unit& u) const {
        const long L = (long)i * G + c; if (L >= nwg) return false;
        int wgid = (int)L; { const int q = nwg / NXCD, r = nwg % NXCD, xcd = wgid % NXCD, off = wgid / NXCD; wgid = (xcd < r ? xcd * (q + 1) : r * (q + 1) + (xcd - r) * q) + off; }
        const int nig = WGM * nN, gid = wgid / nig, fm = gid * WGM, gsz = (nM - fm) < WGM ? (nM - fm) : WGM;
        u.pm = fm + ((wgid % nig) % gsz); u.pn = (wgid % nig) / gsz; return true;
    }
    __device__ __forceinline__ void a_ready(const Unit&) const {}
    __device__ __forceinline__ void done(const Unit&) const {}
};

__device__ __forceinline__ unsigned cvt_pk_bf16(float lo, float hi) { unsigned r; asm volatile("v_cvt_pk_bf16_f32 %0, %1, %2" : "=v"(r) : "v"(lo), "v"(hi)); return r; }
typedef float f32x2 __attribute__((ext_vector_type(2)));
struct EpiBf16 {
    static constexpr bool PERM = true, AFTER_DRAIN = false;
    bf16_t* O; int ldc;
    __device__ __forceinline__ void operator()(const f32x4 (&acc)[2][2][4][2], const Unit& u, int wr, int wc, int fr, int fq) const {
        const int row0 = u.pm * BM + wr * 64 + fr, col0 = u.pn * BM + wc * 32 + 8 * fq;
#pragma unroll
        for (int ai = 0; ai < 2; ++ai)
#pragma unroll
            for (int m = 0; m < 4; ++m) { bf16_t* rowp = O + (size_t)(row0 + ai * HALF + m * 16) * ldc + col0;
#pragma unroll
                for (int bj = 0; bj < 2; ++bj) { const f32x4 v0 = acc[ai][bj][m][0], v1 = acc[ai][bj][m][1];
                    u32x4 w; w.x = cvt_pk_bf16(v0[0], v0[1]); w.y = cvt_pk_bf16(v0[2], v0[3]); w.z = cvt_pk_bf16(v1[0], v1[1]); w.w = cvt_pk_bf16(v1[2], v1[3]);
                    st16_wt(rowp + bj * HALF, w); } }
    }
};
struct EpiF32 {
    static constexpr bool PERM = true, AFTER_DRAIN = false;
    float* O; int ldc;
    __device__ __forceinline__ void operator()(const f32x4 (&acc)[2][2][4][2], const Unit& u, int wr, int wc, int fr, int fq) const {
        const int row0 = u.pm * BM + wr * 64 + fr, col0 = u.pn * BM + wc * 32 + 8 * fq;
#pragma unroll
        for (int ai = 0; ai < 2; ++ai)
#pragma unroll
            for (int m = 0; m < 4; ++m) { float* rowp = O + (size_t)(row0 + ai * HALF + m * 16) * ldc + col0;
#pragma unroll
                for (int bj = 0; bj < 2; ++bj) { *(f32x4*)(rowp + bj * HALF) = acc[ai][bj][m][0]; *(f32x4*)(rowp + bj * HALF + 4) = acc[ai][bj][m][1]; } }
    }
};
__device__ __forceinline__ float silu_mul(float g, float u) { return g * __builtin_amdgcn_rcpf(1.0f + __expf(-g)) * u; }
struct EpiSwiglu {
    static constexpr bool PERM = true, AFTER_DRAIN = false;
    bf16_t* O; int ldc;
    __device__ __forceinline__ void operator()(const f32x4 (&acc)[2][2][4][2], const Unit& u, int wr, int wc, int fr, int fq) const {
        const int row0 = u.pm * BM + wr * 64 + fr, col0 = u.pn * HALF + wc * 32 + 8 * fq;
#pragma unroll
        for (int ai = 0; ai < 2; ++ai)
#pragma unroll
            for (int m = 0; m < 4; ++m) { bf16_t* rowp = O + (size_t)(row0 + ai * HALF + m * 16) * ldc + col0;
                const f32x4 g0 = acc[ai][0][m][0], g1 = acc[ai][0][m][1], u0 = acc[ai][1][m][0], u1 = acc[ai][1][m][1];
                u32x4 w; w.x = cvt_pk_bf16(silu_mul(g0[0], u0[0]), silu_mul(g0[1], u0[1])); w.y = cvt_pk_bf16(silu_mul(g0[2], u0[2]), silu_mul(g0[3], u0[3]));
                w.z = cvt_pk_bf16(silu_mul(g1[0], u1[0]), silu_mul(g1[1], u1[1])); w.w = cvt_pk_bf16(silu_mul(g1[2], u1[2]), silu_mul(g1[3], u1[3]));
                st16_wt(rowp, w); }
    }
};

struct OrderX {
    StaticOrder so; int skipctx;
    __device__ void init(int M, int N, int G_, int c_, bool skip) { so.init(skip ? M - 4 * BM : M, N, G_, c_); skipctx = skip ? 1 : 0; }
    __device__ bool next(int i, Unit& u) const { const bool ok = so.next(i, u); if (ok && skipctx) u.pm = u.pm + u.pm / 32 + 1; return ok; }
    __device__ __forceinline__ void a_ready(const Unit&) const {}
    __device__ __forceinline__ void done(const Unit&) const {}
};
struct OrderCtx2 {
    int c;
    __device__ bool next(int i, Unit& u) const { if (i != 0 || c >= 32) return false; u.pm = c >> 3; u.pn = (c >> 1) & 3; return true; }
    __device__ __forceinline__ void a_ready(const Unit&) const {}
    __device__ __forceinline__ void done(const Unit&) const {}
};
struct OrderCtx {
    int c;
    __device__ bool next(int i, Unit& u) const { if (i != 0 || c >= 16) return false; u.pm = 33 * (c >> 2); u.pn = c & 3; return true; }
    __device__ __forceinline__ void a_ready(const Unit&) const {}
    __device__ __forceinline__ void done(const Unit&) const {}
};
template <class Epi, class Sched, bool ALIGN_EPI = false, bool SP2 = false>
__device__ __forceinline__ void gemm_phase(PG8_LAS unsigned char* lds, const Gemm g, const Sched& S, const Epi& E) {
    const int tid = tidx(), wid = __builtin_amdgcn_readfirstlane(tid >> 6), lane = tid & 63, wr = wid >> 2, wc = wid & 3, fr = lane & 15, fq = lane >> 4;
    const int K = g.K, nt = K / BK, LD = g.ld ? g.ld : g.K;
    unsigned voffA[2], voffB[2];
#pragma unroll
    for (int i = 0; i < 2; ++i) { int R, C; stage_rc(tid * 16 + i * 8192, R, C); const int Rb = Epi::PERM ? ((R & ~31) + perm32(R & 31)) : R;
        voffA[i] = (unsigned)(R * LD + C) * 2u; voffB[i] = (unsigned)(Rb * LD + C) * 2u; }
    const size_t kstep = (size_t)(BK * 2);
    const size_t hstep = (size_t)HALF * LD * 2;
    const size_t tstep = 2 * hstep;
    const unsigned ldsw = (unsigned)wid * 1024u;
    const int aoff = lds_byte(wr * 64 + fr, fq * 8), boff = lds_byte(wc * 32 + fr, fq * 8);
#define PG8_SA(b, h) (((b) * 2 + (h)) * HTB)
#define PG8_SB(b, h) ((4 + (b) * 2 + (h)) * HTB)
#define PG8_STAGE(bufoff, gbase, voff) do { _Pragma("unroll") for (int _i = 0; _i < 2; ++_i) \
        __builtin_amdgcn_global_load_lds((const unsigned*)((const char*)(gbase) + (voff)[_i]), (PG8_LAS unsigned*)(lds + (bufoff) + ldsw + _i * 8192), 16, 0, 0); } while (0)
#define PG8_LDA(dst, b, h) do { _Pragma("unroll") for (int m = 0; m < 4; ++m) _Pragma("unroll") for (int k = 0; k < 2; ++k) dst[m][k] = *(const PG8_LAS bf16x8*)(lds + PG8_SA(b, h) + aoff + m * 2048 + k * 1024); } while (0)
#define PG8_LDB(dst, b, h) do { _Pragma("unroll") for (int n = 0; n < 2; ++n) _Pragma("unroll") for (int k = 0; k < 2; ++k) dst[n][k] = *(const PG8_LAS bf16x8*)(lds + PG8_SB(b, h) + boff + n * 2048 + k * 1024); } while (0)
#define PG8_MMA(ai, bj, At, Bt) do { __builtin_amdgcn_s_setprio(1); _Pragma("unroll") for (int m = 0; m < 4; ++m) _Pragma("unroll") for (int n = 0; n < 2; ++n) _Pragma("unroll") for (int k = 0; k < 2; ++k) \
        acc[ai][bj][m][n] = __builtin_amdgcn_mfma_f32_16x16x32_bf16(Bt[n][k], At[m][k], acc[ai][bj][m][n], 0, 0, 0); __builtin_amdgcn_s_setprio(0); } while (0)
#define PG8_WAIT_V(n) asm volatile("s_waitcnt vmcnt(" #n ")" ::: "memory")
#define PG8_WAIT_L(n) asm volatile("s_waitcnt lgkmcnt(" #n ")" ::: "memory")
#define PG8_BAR __builtin_amdgcn_s_barrier()
#define PG8_SCHED __builtin_amdgcn_sched_barrier(0)
    Unit cur, nxt; int ui = 0;
    if (!S.next(0, cur)) return;
    f32x4 acc[2][2][4][2];
#pragma unroll
    for (int a = 0; a < 2; ++a)
#pragma unroll
        for (int b = 0; b < 2; ++b)
#pragma unroll
            for (int m = 0; m < 4; ++m)
#pragma unroll
                for (int n = 0; n < 2; ++n) acc[a][b][m][n] = (f32x4){0.f, 0.f, 0.f, 0.f};
    bf16x8 At[4][2], B0[2][2], B1[2][2];
    const char* cA = (const char*)g.A + (size_t)cur.pm * tstep; const char* cB = (const char*)g.Bt + (size_t)cur.pn * tstep;
    S.a_ready(cur);
    if constexpr (SP2) {
        PG8_STAGE(PG8_SB(0, 0), cB, voffB); PG8_STAGE(PG8_SB(0, 1), cB + hstep, voffB); PG8_STAGE(PG8_SA(0, 0), cA, voffA); PG8_STAGE(PG8_SA(0, 1), cA + hstep, voffA);
        if (wr == 1) PG8_BAR;
        PG8_WAIT_V(2); PG8_BAR;
        PG8_STAGE(PG8_SB(1, 0), cB + kstep, voffB); PG8_STAGE(PG8_SA(1, 0), cA + kstep, voffA); PG8_STAGE(PG8_SB(1, 1), cB + hstep + kstep, voffB);
        PG8_WAIT_V(6); PG8_BAR;
    } else {
        PG8_STAGE(PG8_SB(0, 0), cB, voffB); PG8_STAGE(PG8_SA(0, 0), cA, voffA); PG8_STAGE(PG8_SB(0, 1), cB + hstep, voffB); PG8_STAGE(PG8_SA(0, 1), cA + hstep, voffA);
        if (wr == 1) PG8_BAR;
        PG8_WAIT_V(4); PG8_BAR;
        PG8_STAGE(PG8_SB(1, 0), cB + kstep, voffB); PG8_STAGE(PG8_SA(1, 0), cA + kstep, voffA); PG8_STAGE(PG8_SB(1, 1), cB + hstep + kstep, voffB);
        PG8_WAIT_V(6); PG8_BAR;
    }
    for (;;) {
        const bool has_next = S.next(ui + 1, nxt);
        const char* nA = has_next ? (const char*)g.A + (size_t)nxt.pm * tstep : cA; const char* nB = has_next ? (const char*)g.Bt + (size_t)nxt.pn * tstep : cB;
        for (int t = 0; t < nt; t += 2) {
            const bool last = (t == nt - 2);
            const char* a1 = cA + (size_t)(t + 1) * kstep;
            const char* a2 = last ? nA : cA + (size_t)(t + 2) * kstep; const char* b2 = last ? nB : cB + (size_t)(t + 2) * kstep;
            const char* a3 = a2 + kstep; const char* b3 = b2 + kstep;
            if (last && has_next) S.a_ready(nxt);
            if constexpr (SP2) {
            PG8_LDB(B0, 0, 0); PG8_LDB(B1, 0, 1); PG8_SCHED; PG8_LDA(At, 0, 0); PG8_STAGE(PG8_SA(1, 1), a1 + hstep, voffA);
            PG8_WAIT_V(8); PG8_WAIT_L(0); PG8_BAR; PG8_MMA(0, 0, At, B0); PG8_MMA(0, 1, At, B1); PG8_BAR; PG8_SCHED;
            PG8_LDA(At, 0, 1); PG8_STAGE(PG8_SB(0, 0), b2, voffB); PG8_STAGE(PG8_SB(0, 1), b2 + hstep, voffB); PG8_STAGE(PG8_SA(0, 0), a2, voffA);
            PG8_WAIT_V(8); PG8_WAIT_L(0); PG8_BAR; PG8_MMA(1, 0, At, B0); PG8_MMA(1, 1, At, B1); PG8_BAR; PG8_SCHED;
            PG8_LDB(B0, 1, 0); PG8_LDB(B1, 1, 1); PG8_SCHED; PG8_LDA(At, 1, 0); PG8_STAGE(PG8_SA(0, 1), a2 + hstep, voffA);
            PG8_WAIT_V(8); PG8_WAIT_L(0); PG8_BAR; PG8_MMA(0, 0, At, B0); PG8_MMA(0, 1, At, B1); PG8_BAR; PG8_SCHED;
            PG8_LDA(At, 1, 1); PG8_STAGE(PG8_SB(1, 0), b3, voffB); PG8_STAGE(PG8_SB(1, 1), b3 + hstep, voffB); PG8_STAGE(PG8_SA(1, 0), a3, voffA);
            PG8_WAIT_V(8); PG8_WAIT_L(0); PG8_BAR; PG8_MMA(1, 0, At, B0); PG8_MMA(1, 1, At, B1); PG8_BAR; PG8_SCHED;
            } else {
            PG8_LDB(B0, 0, 0); PG8_SCHED; PG8_LDA(At, 0, 0); PG8_STAGE(PG8_SA(1, 1), a1 + hstep, voffA);
            PG8_WAIT_L(8); PG8_BAR; PG8_WAIT_L(0); PG8_MMA(0, 0, At, B0); PG8_BAR; PG8_SCHED;
            PG8_LDB(B1, 0, 1); PG8_STAGE(PG8_SB(0, 0), b2, voffB);
            PG8_BAR; PG8_WAIT_L(0); PG8_MMA(0, 1, At, B1); PG8_BAR;
            PG8_LDA(At, 0, 1); PG8_STAGE(PG8_SA(0, 0), a2, voffA);
            PG8_BAR; PG8_WAIT_L(0); PG8_MMA(1, 0, At, B0); PG8_BAR; PG8_SCHED;
            PG8_STAGE(PG8_SB(0, 1), b2 + hstep, voffB);
            PG8_WAIT_V(6); PG8_BAR; PG8_MMA(1, 1, At, B1); PG8_BAR;
            PG8_LDB(B0, 1, 0); PG8_SCHED; PG8_LDA(At, 1, 0); PG8_STAGE(PG8_SA(0, 1), a2 + hstep, voffA);
            PG8_WAIT_L(8); PG8_BAR; PG8_WAIT_L(0); PG8_MMA(0, 0, At, B0); PG8_BAR; PG8_SCHED;
            PG8_LDB(B1, 1, 1); PG8_STAGE(PG8_SB(1, 0), b3, voffB);
            PG8_BAR; PG8_WAIT_L(0); PG8_MMA(0, 1, At, B1); PG8_BAR;
            PG8_LDA(At, 1, 1); PG8_STAGE(PG8_SA(1, 0), a3, voffA);
            PG8_BAR; PG8_WAIT_L(0); PG8_MMA(1, 0, At, B0); PG8_BAR; PG8_SCHED;
            PG8_STAGE(PG8_SB(1, 1), b3 + hstep, voffB);
            PG8_WAIT_V(6); PG8_BAR; PG8_MMA(1, 1, At, B1); PG8_BAR;
            }
        }
        if constexpr (ALIGN_EPI) { if (wr == 0) PG8_BAR; }
        if constexpr (!Epi::AFTER_DRAIN) { E(acc, cur, wr, wc, fr, fq); S.done(cur); }
        if (!has_next) break;
#pragma unroll
        for (int a = 0; a < 2; ++a)
#pragma unroll
            for (int b = 0; b < 2; ++b)
#pragma unroll
                for (int m = 0; m < 4; ++m)
#pragma unroll
                    for (int n = 0; n < 2; ++n) acc[a][b][m][n] = (f32x4){0.f, 0.f, 0.f, 0.f};
        cur = nxt; cA = nA; cB = nB; ++ui;
        if constexpr (ALIGN_EPI) { if (wr == 1) PG8_BAR; }
    }
    PG8_WAIT_V(0);
    if constexpr (!ALIGN_EPI) { if (wr == 0) PG8_BAR; }
    PG8_BAR;
    if constexpr (Epi::AFTER_DRAIN) { E.fused(acc, cur, wr, wc, fr, fq, lds, wid, lane); S.done(cur); }
#undef PG8_SA
#undef PG8_SB
#undef PG8_STAGE
#undef PG8_LDA
#undef PG8_LDB
#undef PG8_MMA
#undef PG8_WAIT_V
#undef PG8_WAIT_L
#undef PG8_BAR
#undef PG8_SCHED
}
}
namespace att {
using bf16 = unsigned short;
using bf16x8 = __attribute__((ext_vector_type(8))) short;
using s16x4  = __attribute__((ext_vector_type(4))) short;
using f32x16 = __attribute__((ext_vector_type(16))) float;
using u32x4  = __attribute__((ext_vector_type(4))) unsigned;
constexpr int NW = 8, QBLK = 32, KVBLK = 64;
constexpr float THR = 8.f;
#define ATT_SBAR() __builtin_amdgcn_sched_barrier(0)
__device__ __forceinline__ int crow(int r, int hi) { return (r & 3) + 8 * (r >> 2) + 4 * hi; }
__device__ __forceinline__ unsigned cvtpk(float lo, float hi) { unsigned r; asm volatile("v_cvt_pk_bf16_f32 %0, %1, %2" : "=v"(r) : "v"(lo), "v"(hi)); return r; }
template <int DH> struct Cfg {
    static constexpr int ND = DH / 16, NO = DH / 32, NCB = DH / 32, NLD = DH / 64, CPR = DH / 8, ROWB = DH * 2;
    static constexpr int SHM_T = KVBLK * DH * 2;
    static constexpr int SHM = 4 * SHM_T + NW * 64 * 4;
    static constexpr float SCALE = DH == 64 ? 0.125f : 0.088388347648318440f;
    static constexpr float C = SCALE * 1.4426950408889634f;
};
template <int DH> __device__ __forceinline__ int kswz(int row, int colB) { return row * Cfg<DH>::ROWB + (colB ^ ((row & 7) << 4)); }

template <int DH> __device__ __forceinline__ void partialSM(f32x16& p0, f32x16& p1, float& m_reg, float& mn, float& alpha) {
    constexpr float C = Cfg<DH>::C, SCALE = Cfg<DH>::SCALE;
    float pmax = p0[0];
#pragma unroll
    for (int r = 1; r < 16; ++r) pmax = fmaxf(pmax, p0[r]);
#pragma unroll
    for (int r = 0; r < 16; ++r) pmax = fmaxf(pmax, p1[r]);
    { auto rr = __builtin_amdgcn_permlane32_swap(__float_as_uint(pmax), __float_as_uint(pmax), false, false);
      pmax = fmaxf(__uint_as_float(rr[0]), __uint_as_float(rr[1])); }
    if (__builtin_expect(__all(pmax - m_reg <= THR / SCALE), 1)) { mn = m_reg; alpha = 1.f; }
    else { mn = fmaxf(m_reg, pmax); alpha = __builtin_amdgcn_exp2f((m_reg - mn) * C); m_reg = mn; }
    const float mnC = -mn * C;
#pragma unroll
    for (int r = 0; r < 16; ++r) p0[r] = fmaf(p0[r], C, mnC);
#pragma unroll
    for (int r = 0; r < 16; ++r) p1[r] = fmaf(p1[r], C, mnC);
#pragma unroll
    for (int r = 0; r < 16; ++r) p0[r] = __builtin_amdgcn_exp2f(p0[r]);
}
__device__ __forceinline__ void finishSM(f32x16& p0, f32x16& p1, float alpha, float& l_reg, bf16x8& pa0, bf16x8& pa1, bf16x8& pa2, bf16x8& pa3) {
#pragma unroll
    for (int r = 0; r < 16; ++r) p1[r] = __builtin_amdgcn_exp2f(p1[r]);
    float ps = 0;
#pragma unroll
    for (int r = 0; r < 16; ++r) ps += p0[r];
#pragma unroll
    for (int r = 0; r < 16; ++r) ps += p1[r];
    { auto rr = __builtin_amdgcn_permlane32_swap(__float_as_uint(ps), __float_as_uint(ps), false, false);
      ps = __uint_as_float(rr[0]) + __uint_as_float(rr[1]); }
    l_reg = l_reg * alpha + ps;
#define ATT_PK4(P, BASE, OUT) do { unsigned a0 = cvtpk(P[BASE + 0], P[BASE + 1]), a1 = cvtpk(P[BASE + 2], P[BASE + 3]);   \
    unsigned b0 = cvtpk(P[BASE + 4], P[BASE + 5]), b1 = cvtpk(P[BASE + 6], P[BASE + 7]);                              \
    auto r0 = __builtin_amdgcn_permlane32_swap(a0, b0, false, false); auto r1 = __builtin_amdgcn_permlane32_swap(a1, b1, false, false); \
    u32x4 w = {r0[0], r1[0], r0[1], r1[1]}; OUT = *reinterpret_cast<bf16x8*>(&w); } while (0)
    ATT_PK4(p0, 0, pa0); ATT_PK4(p0, 8, pa1); ATT_PK4(p1, 0, pa2); ATT_PK4(p1, 8, pa3);
#undef ATT_PK4
}
template <int DH> __device__ __forceinline__ void qkt(f32x16& p0, f32x16& p1, const char* Ks, const bf16x8* qr, int r32, int hi) {
    p0 = f32x16{}; p1 = f32x16{};
#pragma unroll
    for (int d0 = 0; d0 < Cfg<DH>::ND; ++d0) { const int cb = (d0 * 16 + hi * 8) * 2;
        const bf16x8 b0 = *reinterpret_cast<const bf16x8*>(Ks + kswz<DH>(r32, cb));
        const bf16x8 b1 = *reinterpret_cast<const bf16x8*>(Ks + kswz<DH>(32 + r32, cb));
        p0 = __builtin_amdgcn_mfma_f32_32x32x16_bf16(b0, qr[d0], p0, 0, 0, 0);
        p1 = __builtin_amdgcn_mfma_f32_32x32x16_bf16(b1, qr[d0], p1, 0, 0, 0); }
}
__device__ __forceinline__ void maskp(f32x16& p0, f32x16& p1, int kb, int qpos, int hi) {
    const int d0 = kb + 4 * hi - qpos;
#pragma unroll
    for (int r = 0; r < 16; ++r) { const int d = d0 + (r & 3) + 8 * (r >> 2);
        if (d > 128 || d < -128) p0[r] = -INFINITY;
        if (d + 32 > 128 || d + 32 < -128) p1[r] = -INFINITY; }
}
template <int DH> __device__ __forceinline__ int v_st(int k, int c) { const int kk = (k & ~0xC) | ((k & 4) << 1) | ((k & 8) >> 1); return ((kk >> 3) * Cfg<DH>::NCB + (c >> 5)) * 512 + ((kk & 7) * 32 + (c & 31)) * 2; }
__device__ __forceinline__ int v_rd_base(int lane) { return ((lane & 3) << 3) | (((lane >> 2) & 3) << 6) | (((lane >> 4) & 1) << 5) | (((lane >> 5) & 1) << 8); }
template <int OFF> __device__ __forceinline__ s16x4 tr_read(int vb) { s16x4 r; asm volatile("ds_read_b64_tr_b16 %0, %1 offset:%2" : "=&v"(r) : "v"(vb), "i"(OFF) : "memory"); return r; }
template <int DH, int D0> __device__ __forceinline__ void pv_one(f32x16& od, int vb, bf16x8 pa0, bf16x8 pa1, bf16x8 pa2, bf16x8 pa3) {
    constexpr int KS = Cfg<DH>::NCB * 1024, HF = Cfg<DH>::NCB * 512, B0 = D0 * 512;
    const s16x4 l0 = tr_read<B0>(vb), h0 = tr_read<B0 + HF>(vb), l1 = tr_read<B0 + KS>(vb), h1 = tr_read<B0 + KS + HF>(vb);
    const s16x4 l2 = tr_read<B0 + 2 * KS>(vb), h2 = tr_read<B0 + 2 * KS + HF>(vb), l3 = tr_read<B0 + 3 * KS>(vb), h3 = tr_read<B0 + 3 * KS + HF>(vb);
    asm volatile("s_waitcnt lgkmcnt(0)" ::: "memory"); ATT_SBAR();
#define ATT_PK(L, H) (bf16x8){L[0], L[1], L[2], L[3], H[0], H[1], H[2], H[3]}
    od = __builtin_amdgcn_mfma_f32_32x32x16_bf16(pa0, ATT_PK(l0, h0), od, 0, 0, 0);
    od = __builtin_amdgcn_mfma_f32_32x32x16_bf16(pa1, ATT_PK(l1, h1), od, 0, 0, 0);
    od = __builtin_amdgcn_mfma_f32_32x32x16_bf16(pa2, ATT_PK(l2, h2), od, 0, 0, 0);
    od = __builtin_amdgcn_mfma_f32_32x32x16_bf16(pa3, ATT_PK(l3, h3), od, 0, 0, 0);
#undef ATT_PK
}
template <int DH> __device__ __forceinline__ void pv_all(f32x16* o, int vb, bf16x8 pa0, bf16x8 pa1, bf16x8 pa2, bf16x8 pa3) {
    pv_one<DH, 0>(o[0], vb, pa0, pa1, pa2, pa3); pv_one<DH, 1>(o[1], vb, pa0, pa1, pa2, pa3);
    if constexpr (DH == 128) { pv_one<DH, 2>(o[2], vb, pa0, pa1, pa2, pa3); pv_one<DH, 3>(o[3], vb, pa0, pa1, pa2, pa3); }
}

template <int DH, int LDQ, int LDK, int LDO, int VOFF, bool MASK, int QPREP, int HS = 256>
__device__ __forceinline__ void attn_body(const bf16* __restrict__ Qb, const bf16* __restrict__ Kh, bf16* __restrict__ Ob,
                                          int NT, int band0, int q0, float sinkl2, const float* __restrict__ qgain, const float* __restrict__ qtab, char* lds, float sinkl2b = 0.f) {
    using CF = Cfg<DH>;
    constexpr int SHM_T = CF::SHM_T, NLD = CF::NLD, CPR = CF::CPR, NO = CF::NO, ND = CF::ND, SD = 2;
    const int tid = tidx(), wid = tid >> 6, lane = tid & 63, r32 = lane & 31, hi = lane >> 5;
    constexpr int WPH = HS / QBLK; const int hsel = wid / WPH, wrow = (wid % WPH) * QBLK;
    char* V_lds = lds; char* K_lds = lds + 2 * SHM_T;
    float* wsf = (float*)(lds + 4 * SHM_T) + wid * 64; float* li_l = wsf; float* al_l = wsf + 32;
    float m_reg = -1e30f, l_reg = 0; f32x16 o[NO]; bf16x8 qr[ND];
#pragma unroll
    for (int d = 0; d < NO; ++d) o[d] = f32x16{};
    const bf16* Qw = Qb + hsel * DH + (long)(wrow + r32) * LDQ + hi * 8;
#pragma unroll
    for (int d0 = 0; d0 < ND; ++d0) qr[d0] = *reinterpret_cast<const bf16x8*>(Qw + d0 * 16);
    if constexpr (QPREP != 0) {
        float qf[ND][8];
#pragma unroll
        for (int d0 = 0; d0 < ND; ++d0)
#pragma unroll
            for (int e = 0; e < 8; ++e) { const unsigned short hv = (unsigned short)qr[d0][e]; qf[d0][e] = __uint_as_float((unsigned)hv << 16); }
        if constexpr ((QPREP & 2) != 0) {
            float ss = 0.f;
#pragma unroll
            for (int d0 = 0; d0 < ND; ++d0)
#pragma unroll
                for (int e = 0; e < 8; ++e) ss += qf[d0][e] * qf[d0][e];
            { auto rr = __builtin_amdgcn_permlane32_swap(__float_as_uint(ss), __float_as_uint(ss), false, false); ss = __uint_as_float(rr[0]) + __uint_as_float(rr[1]); }
            const float rs = rsqrtf(ss * (1.0f / DH) + 1e-6f);
#pragma unroll
            for (int d0 = 0; d0 < ND; ++d0) { const float4 g0 = *reinterpret_cast<const float4*>(qgain + d0 * 16 + hi * 8), g1 = *reinterpret_cast<const float4*>(qgain + d0 * 16 + hi * 8 + 4);
                qf[d0][0] *= rs * g0.x; qf[d0][1] *= rs * g0.y; qf[d0][2] *= rs * g0.z; qf[d0][3] *= rs * g0.w; qf[d0][4] *= rs * g1.x; qf[d0][5] *= rs * g1.y; qf[d0][6] *= rs * g1.z; qf[d0][7] *= rs * g1.w; }
        }
        if constexpr ((QPREP & 1) != 0) {
            const float* tb = qtab + ((long)(wrow + r32) * (DH / 2) + hi * 4) * 2;
#pragma unroll
            for (int d0 = 0; d0 < ND; ++d0) { const float4 t0 = *reinterpret_cast<const float4*>(tb + d0 * 16), t1 = *reinterpret_cast<const float4*>(tb + d0 * 16 + 4);
                const float c[4] = {t0.x, t0.z, t1.x, t1.z}, sn[4] = {t0.y, t0.w, t1.y, t1.w};
#pragma unroll
                for (int i = 0; i < 4; ++i) { const float a = qf[d0][2 * i], b = qf[d0][2 * i + 1]; qf[d0][2 * i] = a * c[i] - b * sn[i]; qf[d0][2 * i + 1] = a * sn[i] + b * c[i]; } }
        }
#pragma unroll
        for (int d0 = 0; d0 < ND; ++d0) { u32x4 w = {cvtpk(qf[d0][0], qf[d0][1]), cvtpk(qf[d0][2], qf[d0][3]), cvtpk(qf[d0][4], qf[d0][5]), cvtpk(qf[d0][6], qf[d0][7])}; qr[d0] = *reinterpret_cast<bf16x8*>(&w); }
    }
    const int sr0 = tid / CPR, sc0 = (tid % CPR) * 8, goff0 = sr0 * LDK + sc0, vst0 = v_st<DH>(sr0, sc0), kst0 = kswz<DH>(sr0, sc0 * 2);
    constexpr int RSTEP = 512 / CPR, GSTEP = RSTEP * LDK, VSTEP = (RSTEP >> 3) * CF::NCB * 512, KSTEP = RSTEP * CF::ROWB;
    static_assert(NLD == 1 || (RSTEP % 16 == 0), "piece step keeps the row's low four bits (V key-bit swap and K swizzle unchanged)");
    const int vb0 = (int)(uintptr_t)V_lds + v_rd_base(lane);
    const int qpos = q0 + wrow + r32;
    struct { bf16x8 v[NLD], k[NLD]; } sr_[SD];
#define ATT_KROW(j) (64 * (j) + ((j) >= 4 ? band0 : 0))
#define ATT_SLOAD(i, j) do { const bf16* kp_ = Kh + (long)ATT_KROW(j) * LDK; _Pragma("unroll") for (int q_ = 0; q_ < NLD; ++q_) { \
        sr_[i].v[q_] = *reinterpret_cast<const bf16x8*>(kp_ + goff0 + q_ * GSTEP + VOFF); sr_[i].k[q_] = *reinterpret_cast<const bf16x8*>(kp_ + goff0 + q_ * GSTEP); } } while (0)
#define ATT_SWRITE(b, i) do { _Pragma("unroll") for (int q_ = 0; q_ < NLD; ++q_) { *(bf16x8*)(V_lds + (b) * SHM_T + vst0 + q_ * VSTEP) = sr_[i].v[q_]; *(bf16x8*)(K_lds + (b) * SHM_T + kst0 + q_ * KSTEP) = sr_[i].k[q_]; } } while (0)
#define ATT_SWAIT() do { if constexpr (SD == 1) asm volatile("s_waitcnt vmcnt(0)" ::: "memory"); else if constexpr (NLD == 2) asm volatile("s_waitcnt vmcnt(4)" ::: "memory"); else asm volatile("s_waitcnt vmcnt(2)" ::: "memory"); } while (0)
#define ATT_RESC(a) do { if (__any((a) < 1.f)) { if (hi == 0) al_l[r32] = (a); asm volatile("s_waitcnt lgkmcnt(0)" ::: "memory"); \
        _Pragma("unroll") for (int d = 0; d < NO; ++d) _Pragma("unroll") for (int r = 0; r < 16; ++r) o[d][r] *= al_l[crow(r, hi)]; } } while (0)
#define ATT_MASK(P0, P1, j) do { if constexpr (MASK) { if ((j) >= 4) maskp(P0, P1, band0 + 64 * ((j) - 4), qpos, hi); } } while (0)
    f32x16 pA0, pA1, pB0, pB1; float mnA, mnB, alA, alB; bf16x8 pa0, pa1, pa2, pa3;
    constexpr int SE = 0, SO = SD - 1;
    ATT_SLOAD(SE, 0); asm volatile("s_waitcnt vmcnt(0)" ::: "memory"); ATT_SWRITE(0, SE); __syncthreads();
    qkt<DH>(pA0, pA1, K_lds, qr, r32, hi); ATT_MASK(pA0, pA1, 0); partialSM<DH>(pA0, pA1, m_reg, mnA, alA);
    ATT_SLOAD(SO, 1); if constexpr (SD == 2) { if (2 < NT) ATT_SLOAD(SE, 2); }
    ATT_SWAIT(); ATT_SWRITE(1, SO); __syncthreads();
    for (int j = 1; j + 1 < NT; j += 2) {
        ATT_SBAR(); qkt<DH>(pB0, pB1, K_lds + SHM_T, qr, r32, hi); ATT_MASK(pB0, pB1, j);
        finishSM(pA0, pA1, alA, l_reg, pa0, pa1, pa2, pa3); ATT_SBAR();
        ATT_SLOAD(SO, j + SD); ATT_SBAR();
        pv_all<DH>(o, vb0, pa0, pa1, pa2, pa3); partialSM<DH>(pB0, pB1, m_reg, mnB, alB);
        __syncthreads(); ATT_SWAIT(); ATT_SWRITE(0, SE);
        ATT_RESC(alB); __syncthreads();
        ATT_SBAR(); qkt<DH>(pA0, pA1, K_lds, qr, r32, hi); ATT_MASK(pA0, pA1, j + 1);
        finishSM(pB0, pB1, alB, l_reg, pa0, pa1, pa2, pa3); ATT_SBAR();
        if (SD == 1 || j + 3 < NT) ATT_SLOAD(SE, j + 1 + SD); ATT_SBAR();
        pv_all<DH>(o, vb0 + SHM_T, pa0, pa1, pa2, pa3); partialSM<DH>(pA0, pA1, m_reg, mnA, alA);
        __syncthreads(); ATT_SWAIT(); ATT_SWRITE(1, SO);
        ATT_RESC(alA); __syncthreads();
    }
    ATT_SBAR(); qkt<DH>(pB0, pB1, K_lds + SHM_T, qr, r32, hi); ATT_MASK(pB0, pB1, NT - 1);
    finishSM(pA0, pA1, alA, l_reg, pa0, pa1, pa2, pa3); ATT_SBAR();
    pv_all<DH>(o, vb0, pa0, pa1, pa2, pa3); partialSM<DH>(pB0, pB1, m_reg, mnB, alB);
    __syncthreads(); ATT_RESC(alB);
    finishSM(pB0, pB1, alB, l_reg, pa0, pa1, pa2, pa3); ATT_SBAR();
    pv_all<DH>(o, vb0 + SHM_T, pa0, pa1, pa2, pa3);
    l_reg += __builtin_amdgcn_exp2f((hsel ? sinkl2b : sinkl2) - m_reg * CF::C);
    if (hi == 0) li_l[r32] = l_reg; asm volatile("s_waitcnt lgkmcnt(0)" ::: "memory");
    float rli[16];
#pragma unroll
    for (int r = 0; r < 16; ++r) rli[r] = __builtin_amdgcn_rcpf(li_l[crow(r, hi)]);
    bf16* Ow = Ob + hsel * DH + (long)wrow * LDO;
#pragma unroll
    for (int r = 0; r < 16; ++r) { const int orow = crow(r, hi);
#pragma unroll
        for (int d0 = 0; d0 < NO; ++d0) { const unsigned w = cvtpk(o[d0][r] * rli[r], 0.f); Ow[(long)orow * LDO + d0 * 32 + r32] = (bf16)(w & 0xffffu); } }
    __syncthreads();
#undef ATT_KROW
#undef ATT_SLOAD
#undef ATT_SWRITE
#undef ATT_SWAIT
#undef ATT_RESC
#undef ATT_MASK
}
}
#define LAS __attribute__((address_space(3)))
typedef unsigned short bf16;
typedef unsigned v4u __attribute__((ext_vector_type(4)));
typedef float f32x4 __attribute__((ext_vector_type(4)));
typedef short bf16x8 __attribute__((ext_vector_type(8)));
constexpr int NTHR = 512, NWAVES = 8, LDS_BYTES = 155648;

constexpr size_t SZ_X = (size_t)MROWS * DM * 4, SZ_A = (size_t)MROWS * FF * 2, SZ_P = (size_t)MROWS * EVEN_IN * 2, SZ_U = (size_t)MROWS * DM * 2;
constexpr size_t OFF_X = 0, OFF_Y = OFF_X + SZ_X, OFF_A = OFF_Y + SZ_X, OFF_P = OFF_A, OFF_Z = OFF_A + SZ_P, OFF_U = OFF_A + SZ_A;
static_assert(SZ_P + SZ_U == SZ_A, "Z sits in the tail of A");
constexpr size_t SZ_WGU = (size_t)NGU * DM * 2, SZ_WD = (size_t)DM * FF * 2, SZ_WIN = (size_t)EVEN_IN * DM * 2, SZ_WOUT = (size_t)DM * DM * 2, SZ_LW = (size_t)8 * 256 * 64 * 2;
constexpr size_t OFF_WGU0 = OFF_U + SZ_U, OFF_WD0 = OFF_WGU0 + SZ_WGU, OFF_WGU1 = OFF_WD0 + SZ_WD, OFF_WD1 = OFF_WGU1 + SZ_WGU, OFF_WIN = OFF_WD1 + SZ_WD, OFF_WOUT = OFF_WIN + SZ_WIN, OFF_LW = OFF_WOUT + SZ_WOUT;
constexpr size_t OFF_MOD = OFF_LW + SZ_LW, SZ_MOD = (size_t)DEPTH * 5 * NMOD * DM * 4;
constexpr size_t OFF_TABW = OFF_MOD + SZ_MOD, SZ_TABW = (size_t)SEQ * 32 * 2 * 4, OFF_TABG = OFF_TABW + SZ_TABW, SZ_TABG = (size_t)SEQ * 64 * 2 * 4;
constexpr size_t SZ_CH = (size_t)2 * NB * NCHUNK * LRUW * 4, OFF_CHA = OFF_TABG + SZ_TABG, OFF_CHB = OFF_CHA + SZ_CH, OFF_CAR = OFF_CHB + SZ_CH, WS_END = OFF_CAR + SZ_CH;
constexpr size_t OFF_CTL = (WS_END + 255) / 256 * 256, CTL_BYTES = 65536, OFF_PB = OFF_CTL + CTL_BYTES, SZ_PB = (size_t)2 * NB * LCX * DM * 4  , WS_NEED = OFF_PB + SZ_PB;
constexpr int CW_BAR = 0  , CW_PC = 4096  , CW_Q = 4096 + 132 * 64  ;
static_assert((CW_Q + 16 * 64) * 4 <= (int)CTL_BYTES, "control words");
static_assert(WS_NEED <= 603979776ull, "workspace map must fit 4x the largest input");

struct Params { const float* in[25]; float* out; unsigned char* ws; int lo, hi, rep_gemm, rep_att, rep_lru, rep_misc, rep_bar, pad; };
__device__ __forceinline__ const float* pin(const Params& p, int i) { i = __builtin_amdgcn_readfirstlane(i); asm volatile("" : "+s"(i)); return p.in[i]; }
__device__ __forceinline__ unsigned char* pws(const Params& p) { unsigned char* w = p.ws; asm volatile("" : "+s"(w)); return w; }
__device__ __forceinline__ float* pout(const Params& p) { float* w = p.out; asm volatile("" : "+s"(w)); return w; }
enum { I_X = 0, I_C, I_CTX, I_CCTX, I_WADA, I_BADA, I_NPRE, I_NPOST, I_WG, I_WU, I_WDN, I_EWIN, I_ECW, I_ECB, I_LWA, I_LBA, I_LWX, I_LBX, I_LAM, I_SINK, I_EWOUT, I_OWIN, I_OQN, I_OKN, I_OWOUT };

__device__ __forceinline__ unsigned f2bf(float f) { unsigned u = __builtin_bit_cast(unsigned, f); return (u + 0x7fffu + ((u >> 16) & 1u)) >> 16; }
__device__ __forceinline__ unsigned pk2(float lo, float hi) { return f2bf(lo) | (f2bf(hi) << 16); }
__device__ __forceinline__ float bf2f(unsigned short h) { return __builtin_bit_cast(float, (unsigned)h << 16); }
__device__ __forceinline__ float bflo(unsigned w) { return __builtin_bit_cast(float, w << 16); }
__device__ __forceinline__ float bfhi(unsigned w) { return __builtin_bit_cast(float, w & 0xffff0000u); }
__device__ __forceinline__ float wave_sum(float v) {
#pragma unroll
    for (int o = 1; o < 64; o <<= 1) v += __shfl_xor(v, o);
    return v;
}

__device__ __forceinline__ void phase_mod(const Params& p, char* lds) {
    const int tid = tidx(), wid = tid >> 6, lane = tid & 63;
    float* s = (float*)lds;
    float* red = (float*)(lds + 20480);
    for (int i = tid; i < 5 * DM; i += NTHR) { const int v = i >> 10, k = i & 1023; const float c = v < 4 ? pin(p, I_C)[v * DM + k] : pin(p, I_CCTX)[k]; s[i] = c / (1.0f + expf(-c)); }
    __syncthreads();
    float* MOD = (float*)(pws(p) + OFF_MOD);
    for (int tile = bidx(); tile < DEPTH * 72; tile += gridDim.x) {
        const int l = tile / 72, ct = tile % 72, hf = lane >> 5, col = ct * 128 + (lane & 31) * 4;
        const float* W = pin(p, I_WADA) + (size_t)l * DM * (NMOD * DM);
        float acc[5][4];
#pragma unroll
        for (int v = 0; v < 5; ++v)
#pragma unroll
            for (int e = 0; e < 4; ++e) acc[v][e] = 0.f;
#pragma unroll 8
        for (int i = 0; i < 64; ++i) { const int k = wid * 128 + 2 * i + hf; const f32x4 w = *(const f32x4*)(W + (size_t)k * (NMOD * DM) + col);
#pragma unroll
            for (int v = 0; v < 5; ++v) { const float sv = s[v * DM + k]; acc[v][0] += sv * w[0]; acc[v][1] += sv * w[1]; acc[v][2] += sv * w[2]; acc[v][3] += sv * w[3]; } }
#pragma unroll
        for (int v = 0; v < 5; ++v) *(f32x4*)(red + ((wid * 2 + hf) * 5 + v) * 128 + (lane & 31) * 4) = (f32x4){acc[v][0], acc[v][1], acc[v][2], acc[v][3]};
        __syncthreads();
        for (int o = tid; o < 640; o += NTHR) { const int v = o >> 7, cc = o & 127; float sum = 0.f;
#pragma unroll
            for (int q = 0; q < 16; ++q) sum += red[(q * 5 + v) * 128 + cc];
            MOD[(size_t)(l * 5 + v) * (NMOD * DM) + ct * 128 + cc] = sum + pin(p, I_BADA)[l * (NMOD * DM) + ct * 128 + cc]; }
        __syncthreads();
    }
    float* TW = (float*)(pws(p) + OFF_TABW); float* TG = (float*)(pws(p) + OFF_TABG);
    const int gt = bidx() * NTHR + tid, GT = gridDim.x * NTHR;
    for (int i = gt; i < SEQ * 96; i += GT) {
        const int t = i / 96, q = i % 96; const bool win = q < 32; const int pr = win ? q : q - 32, nf = win ? 16 : 32;
        const int f = pr % nf; const float pos = (float)(pr < nf ? t / 64 : t % 64);
        const float freq = expf(-(float)f / (float)nf * 9.210340371976184f);
        const float ang = pos * freq; float sn, cs; sincosf(ang, &sn, &cs);
        float* dst = win ? TW + ((size_t)t * 32 + pr) * 2 : TG + ((size_t)t * 64 + pr) * 2; dst[0] = cs; dst[1] = sn;
    }
}

__device__ __forceinline__ void transpose_item(const float* W, int K, int N, int k0, int n0, bf16* WT, int dst_row0, LAS float* scr, int lane) {
    float tv[32];
#pragma unroll
    for (int i = 0; i < 32; ++i) tv[i] = W[(size_t)(k0 + 2 * i + (lane >> 5)) * N + n0 + (lane & 31)];
#pragma unroll
    for (int i = 0; i < 32; ++i) scr[(2 * i + (lane >> 5)) * 33 + (lane & 31)] = tv[i];
    asm volatile("s_waitcnt lgkmcnt(0)" ::: "memory");
    const int c = lane & 7;
#pragma unroll
    for (int j = 0; j < 4; ++j) { const int n = (lane >> 3) + 8 * j; const LAS float* sp = scr + (8 * c) * 33 + n;
        v4u o; o.x = pk2(sp[0 * 33], sp[1 * 33]); o.y = pk2(sp[2 * 33], sp[3 * 33]); o.z = pk2(sp[4 * 33], sp[5 * 33]); o.w = pk2(sp[6 * 33], sp[7 * 33]);
        *(v4u*)(WT + (size_t)(dst_row0 + n) * K + k0 + 8 * c) = o; }
    asm volatile("s_waitcnt lgkmcnt(0)" ::: "memory");
}
__device__ __forceinline__ void phase_convert(const Params& p, int l, LAS unsigned char* lds) {
    const int tid = tidx(), wid = tid >> 6, lane = tid & 63;
    LAS float* scr = (LAS float*)(lds + wid * 16384);
    const int gw = bidx() * NWAVES + wid, NGW = gridDim.x * NWAVES;
    const bool even = (l & 1) == 0; const int li = l >> 1, nin = even ? EVEN_IN : ODD_IN;
    constexpr int I_G = 16 * (FF / 32), I_D = (FF / 64) * 32;
    const int i_in = 16 * (nin / 32), i_out = 16 * 32, i_lru = even ? 64 : 0;
    const int total = 2 * (2 * I_G + I_D) + i_in + i_out + i_lru;
    for (int it = gw; it < total; it += NGW) {
        int r = it;
        if (r < 2 * (2 * I_G + I_D)) {
            const int f = r / (2 * I_G + I_D); r -= f * (2 * I_G + I_D);
            bf16* wgu = (bf16*)(pws(p) + (f ? OFF_WGU1 : OFF_WGU0)); bf16* wd = (bf16*)(pws(p) + (f ? OFF_WD1 : OFF_WD0));
            const size_t wo = (size_t)(l * 2 + f) * DM * FF;
            if (r < 2 * I_G) { const int up = r / I_G; r -= up * I_G; const int kb = r / (FF / 32), nb = r % (FF / 32), n0 = nb * 32;
                transpose_item(pin(p, up ? I_WU : I_WG) + wo, DM, FF, kb * 64, n0, wgu, 256 * (n0 >> 7) + 128 * up + (n0 & 127), scr, lane); }
            else { r -= 2 * I_G; const int kb = r / 32, nb = r % 32; transpose_item(pin(p, I_WDN) + wo, FF, DM, kb * 64, nb * 32, wd, nb * 32, scr, lane); }
            continue;
        }
        r -= 2 * (2 * I_G + I_D);
        if (r < i_in) { const int nbn = nin / 32, kb = r / nbn, nb = r % nbn;
            transpose_item(even ? pin(p, I_EWIN) + (size_t)li * DM * EVEN_IN : pin(p, I_OWIN) + (size_t)li * DM * ODD_IN, DM, nin, kb * 64, nb * 32, (bf16*)(pws(p) + OFF_WIN), nb * 32, scr, lane); continue; }
        r -= i_in;
        if (r < i_out) { const int kb = r / 32, nb = r % 32;
            transpose_item((even ? pin(p, I_EWOUT) : pin(p, I_OWOUT)) + (size_t)li * DM * DM, DM, DM, kb * 64, nb * 32, (bf16*)(pws(p) + OFF_WOUT), nb * 32, scr, lane); continue; }
        r -= i_out;
        {
            const int nb = r & 1, h = (r >> 1) & 7, g = r >> 4, dir = g >> 1, which = g & 1;
            const float* W = pin(p, which ? I_LWX : I_LWA) + ((size_t)(li * 2 + dir) * 8 + h) * 4096;
            transpose_item(W, 64, 64, 0, nb * 32, (bf16*)(pws(p) + OFF_LW) + (size_t)h * 256 * 64, g * 64 + nb * 32, scr, lane); }
    }
}

struct RowCtx { const float* YP; const float* MOD; unsigned short* XH; unsigned char* XL; const bf16* Y; bf16* U; const float* gpost; const float* gpre; int l, s, pl, pk; float coef; bool first, has_next; };
__device__ __forceinline__ RowCtx rowctx(const Params& p, int l, int s) {
    RowCtx c; c.YP = (const float*)(pws(p) + OFF_PB); c.l = l; c.s = s; c.first = (l == 0 && s == 0); c.has_next = l < DEPTH;
    c.pl = s == 0 ? l - 1 : l; c.pk = s == 0 ? 8 : (s == 1 ? 2 : 5); const int pn = s == 0 ? 2 : (s == 1 ? 0 : 1); c.coef = s == 2 ? 1.0f : 0.5f;
    c.MOD = (const float*)(pws(p) + OFF_MOD); c.XH = (unsigned short*)(pws(p) + OFF_X); c.XL = (unsigned char*)(pws(p) + OFF_X + (size_t)MROWS * DM * 2);     c.Y = (const bf16*)(pws(p) + OFF_Y); c.U = (bf16*)(pws(p) + OFF_U);
    c.gpost = c.first ? nullptr : pin(p, I_NPOST) + (size_t)(c.pl * 3 + pn) * DM;
    c.gpre = c.has_next ? pin(p, I_NPRE) + (size_t)(l * 3 + s) * DM : nullptr;
    return c;
}
template <int NR> struct RowRaw { unsigned long long xh[NR][4]; unsigned xl[NR][4]; unsigned long long yw[NR][4]; };
template <int NR> __device__ __forceinline__ void rp_load(const RowCtx& c, const int (&r)[NR], int lane, RowRaw<NR>& w) {
#pragma unroll
    for (int n = 0; n < NR; ++n) { const unsigned short* xh = c.XH + (size_t)r[n] * DM; const unsigned char* xl = c.XL + (size_t)r[n] * (DM / 2); const bf16* yr = c.Y + (size_t)r[n] * DM;
#pragma unroll
        for (int j = 0; j < 4; ++j) { w.xh[n][j] = *(const unsigned long long*)(xh + 4 * lane + 256 * j); w.xl[n][j] = (*(const unsigned*)(xl + 4 * lane + 256 * (j >> 1)) >> (16 * (j & 1))) & 0xffffu; w.yw[n][j] = *(const unsigned long long*)(yr + 4 * lane + 256 * j); } }
}
#ifndef RP_PREFETCH
#define RP_PREFETCH 0
#endif
struct ModCache { int v; f32x4 ggp[4], gqs[4], sh[4]; };
__device__ __forceinline__ void mc_load(const RowCtx& c, ModCache& mc, int v, int lane) {
    mc.v = v;
    if (!c.first) { const float* gate = c.MOD + ((size_t)(c.pl * 5 + v) * NMOD + c.pk) * DM;
#pragma unroll
        for (int j = 0; j < 4; ++j) mc.ggp[j] = *(const f32x4*)(gate + 4 * lane + 256 * j) * *(const f32x4*)(c.gpost + 4 * lane + 256 * j); }
    if (c.has_next) { const float* sh = c.MOD + ((size_t)(c.l * 5 + v) * NMOD + 3 * c.s) * DM;
#pragma unroll
        for (int j = 0; j < 4; ++j) { mc.sh[j] = *(const f32x4*)(sh + 4 * lane + 256 * j); mc.gqs[j] = *(const f32x4*)(c.gpre + 4 * lane + 256 * j) * (*(const f32x4*)(sh + DM + 4 * lane + 256 * j) + 1.0f); } }
}
template <int NR, bool YPART = false, bool PRE = false>
__device__ __forceinline__ void rowpass_rows(const Params& p, const RowCtx& c, const int (&r)[NR], int lane, ModCache& mc, const RowRaw<NR>* pre = nullptr) {
    int b[NR], rr[NR], v[NR]; bool isc[NR];
    f32x4 x[NR][4]; unsigned long long yw[NR][4];
#pragma unroll
    for (int n = 0; n < NR; ++n) { b[n] = r[n] / SEG; rr[n] = r[n] - b[n] * SEG; isc[n] = rr[n] < LCX; v[n] = isc[n] ? 4 : b[n]; }
    if (c.first) {
#pragma unroll
        for (int n = 0; n < NR; ++n) { const float* src = isc[n] ? pin(p, I_CTX) + ((size_t)b[n] * LCX + rr[n]) * DM : pin(p, I_X) + ((size_t)b[n] * SEQ + (rr[n] - LCX)) * DM;
#pragma unroll
            for (int j = 0; j < 4; ++j) x[n][j] = *(const f32x4*)(src + 4 * lane + 256 * j); }
    } else {
#pragma unroll
        for (int n = 0; n < NR; ++n) { const unsigned short* xh = c.XH + (size_t)r[n] * DM; const unsigned char* xl = c.XL + (size_t)r[n] * (DM / 2); const bf16* yr = c.Y + (size_t)r[n] * DM;
#pragma unroll
            for (int j = 0; j < 4; ++j) { { unsigned long long hw; unsigned lw; if constexpr (PRE) { hw = pre->xh[n][j]; lw = pre->xl[n][j]; } else { hw = *(const unsigned long long*)(xh + 4 * lane + 256 * j); lw = (*(const unsigned*)(xl + 4 * lane + 256 * (j >> 1)) >> (16 * (j & 1))) & 0xffffu; } const unsigned h0 = (unsigned)hw, h1 = (unsigned)(hw >> 32);
                x[n][j] = (f32x4){__builtin_bit_cast(float, (h0 << 16) | ((lw & 0xfu) << 12)), __builtin_bit_cast(float, (h0 & 0xffff0000u) | ((lw << 8) & 0xf000u)), __builtin_bit_cast(float, (h1 << 16) | ((lw << 4) & 0xf000u)), __builtin_bit_cast(float, (h1 & 0xffff0000u) | (lw & 0xf000u))}; }
                if constexpr (PRE) yw[n][j] = pre->yw[n][j]; else if constexpr (!YPART) yw[n][j] = *(const unsigned long long*)(yr + 4 * lane + 256 * j); } }
#pragma unroll
        for (int n = 0; n < NR; ++n) { f32x4 y[4]; float ss = 0.f;
#pragma unroll
            for (int j = 0; j < 4; ++j) { if constexpr (YPART) { const float* y0 = c.YP + (size_t)(b[n] * LCX + rr[n]) * DM + 4 * lane + 256 * j; y[j] = *(const f32x4*)y0 + *(const f32x4*)(y0 + (size_t)NB * LCX * DM); }
                else { const unsigned w0 = (unsigned)yw[n][j], w1 = (unsigned)(yw[n][j] >> 32); y[j] = (f32x4){bflo(w0), bfhi(w0), bflo(w1), bfhi(w1)}; } ss += (y[j][0] * y[j][0] + y[j][1] * y[j][1]) + (y[j][2] * y[j][2] + y[j][3] * y[j][3]); }
            const float rs = rsqrtf(wave_sum(ss) * (1.0f / DM) + EPS) * c.coef;
            if (v[n] != mc.v) mc_load(c, mc, v[n], lane);
#pragma unroll
            for (int j = 0; j < 4; ++j) x[n][j] = x[n][j] + mc.ggp[j] * (y[j] * rs); }
    }
    if (!c.has_next) {
#pragma unroll
        for (int n = 0; n < NR; ++n) if (!isc[n]) { float* o = pout(p) + ((size_t)b[n] * SEQ + (rr[n] - LCX)) * DM;
#pragma unroll
            for (int j = 0; j < 4; ++j) *(f32x4*)(o + 4 * lane + 256 * j) = x[n][j]; }
        return; }
#pragma unroll
    for (int n = 0; n < NR; ++n) { unsigned short* xhw = c.XH + (size_t)r[n] * DM; unsigned char* xlw = c.XL + (size_t)r[n] * (DM / 2); float s2 = 0.f; unsigned nb[4];
#pragma unroll
        for (int j = 0; j < 4; ++j) { { unsigned q[4];
#pragma unroll
                for (int e = 0; e < 4; ++e) { const float xe = x[n][j][e]; q[e] = __builtin_bit_cast(unsigned, xe) + 0x800u; }
                *(unsigned long long*)(xhw + 4 * lane + 256 * j) = (unsigned long long)((q[0] >> 16) | (q[1] & 0xffff0000u)) | ((unsigned long long)((q[2] >> 16) | (q[3] & 0xffff0000u)) << 32);
                nb[j] = ((q[0] >> 12) & 0xfu) | ((q[1] >> 8) & 0xf0u) | ((q[2] >> 4) & 0xf00u) | (q[3] & 0xf000u); }
            s2 += (x[n][j][0] * x[n][j][0] + x[n][j][1] * x[n][j][1]) + (x[n][j][2] * x[n][j][2] + x[n][j][3] * x[n][j][3]); }
        *(unsigned*)(xlw + 4 * lane) = nb[0] | (nb[1] << 16); *(unsigned*)(xlw + 4 * lane + 256) = nb[2] | (nb[3] << 16);
        const float rx = rsqrtf(wave_sum(s2) * (1.0f / DM) + EPS);
        if (v[n] != mc.v) mc_load(c, mc, v[n], lane);
        bf16* ur = c.U + (size_t)r[n] * DM;
#pragma unroll
        for (int j = 0; j < 4; ++j) { const f32x4 u = (x[n][j] * rx) * mc.gqs[j] + mc.sh[j];
            st8_wt(ur + 4 * lane + 256 * j, (unsigned long long)pk2(u[0], u[1]) | ((unsigned long long)pk2(u[2], u[3]) << 32)); } }
}
__device__ __forceinline__ void phase_rowpass(const Params& p, int l, int s, int rows, int cu0, bool ypart = false, int slo = 0) {
    const int tid = tidx(), wid = tid >> 6, lane = tid & 63, bx = bidx(), G_ = (int)gridDim.x;
    const int ntot = rows == 0 ? MROWS : (rows == 1 ? NB * SEQ : NB * LCX);
    int lo = 0, n = ntot, gw, NGW;
    if (cu0 > 0 && slo > 0) { const int nA = (int)((long long)ntot * (G_ - cu0) * 16 / ((G_ - cu0) * 16 + cu0 * slo)) & ~1;
        if (bx >= cu0) { n = nA; gw = (bx - cu0) * NWAVES + wid; NGW = (G_ - cu0) * NWAVES; } else { lo = nA; gw = bx * NWAVES + wid; NGW = cu0 * NWAVES; } }
    else { if (bx < cu0) return; gw = (bx - cu0) * NWAVES + wid; NGW = (G_ - cu0) * NWAVES; }
    const RowCtx c = rowctx(p, l, s);
    ModCache mc; mc.v = -1;
#define RP_ROW(i) (rows == 0 ? (i) : (rows == 1 ? ((i) & 3) * SEG + LCX + ((i) >> 2) : ((i) >> 8) * SEG + ((i) & (LCX - 1))))
    int i = lo + gw;
    if (ypart) { for (; i < n; i += NGW) { const int rr1[1] = {RP_ROW(i)}; rowpass_rows<1, true>(p, c, rr1, lane, mc); } }
    if (RP_PREFETCH && !c.first) {
        RowRaw<2> cur, nxt;
        if (i + NGW < n) { const int r0[2] = {RP_ROW(i), RP_ROW(i + NGW)}; rp_load<2>(c, r0, lane, cur); }
        for (; i + NGW < n; i += 2 * NGW) { const int rr2[2] = {RP_ROW(i), RP_ROW(i + NGW)};
            const bool more = i + 3 * NGW < n; if (more) { const int rn[2] = {RP_ROW(i + 2 * NGW), RP_ROW(i + 3 * NGW)}; rp_load<2>(c, rn, lane, nxt); }
            rowpass_rows<2, false, true>(p, c, rr2, lane, mc, &cur); if (more) cur = nxt; }
    }
    for (; i + NGW < n; i += 2 * NGW) { const int rr2[2] = {RP_ROW(i), RP_ROW(i + NGW)}; rowpass_rows<2>(p, c, rr2, lane, mc); }
    if (i < n) { const int rr1[1] = {RP_ROW(i)}; rowpass_rows<1>(p, c, rr1, lane, mc); }
#undef RP_ROW
}

__device__ __forceinline__ void rope8(float* v, const float* tab) {
    const f32x4 t0 = *(const f32x4*)tab, t1 = *(const f32x4*)(tab + 4);
    const float c[4] = {t0[0], t0[2], t1[0], t1[2]}, sn[4] = {t0[1], t0[3], t1[1], t1[3]};
#pragma unroll
    for (int i = 0; i < 4; ++i) { const float a = v[2 * i], b = v[2 * i + 1]; v[2 * i] = a * c[i] - b * sn[i]; v[2 * i + 1] = a * sn[i] + b * c[i]; }
}
__device__ __forceinline__ void phase_prep(const Params& p, int l) {
    const int gt = bidx() * NTHR + tidx(), GT = gridDim.x * NTHR;
    bf16* P = (bf16*)(pws(p) + OFF_P);
    constexpr int NU = 4;
    if ((l & 1) == 0) {
        const float* TW = (const float*)(pws(p) + OFF_TABW);
        constexpr int NTOT = NB * SEQ * 16;
        for (int i0 = gt; i0 < NTOT; i0 += NU * GT) {
            bf16* ptr[NU]; v4u w[NU]; const float* tb[NU]; bool ok[NU];
#pragma unroll
            for (int u = 0; u < NU; ++u) { const int i = i0 + u * GT; ok[u] = i < NTOT; const int ii = ok[u] ? i : gt;
                const int rl = ii / 16, ch = ii % 16, b = rl / SEQ, t = rl % SEQ; const size_t row = (size_t)b * SEG + LCX + t;
                ptr[u] = P + row * EVEN_IN + 1536 + ch * 8; w[u] = *(const v4u*)ptr[u]; tb[u] = TW + ((size_t)t * 32 + ((ch * 8) & 63) / 2) * 2; }
#pragma unroll
            for (int u = 0; u < NU; ++u) { float v[8] = {bflo(w[u].x), bfhi(w[u].x), bflo(w[u].y), bfhi(w[u].y), bflo(w[u].z), bfhi(w[u].z), bflo(w[u].w), bfhi(w[u].w)};
                rope8(v, tb[u]);
                v4u o; o.x = pk2(v[0], v[1]); o.y = pk2(v[2], v[3]); o.z = pk2(v[4], v[5]); o.w = pk2(v[6], v[7]); if (ok[u]) *(v4u*)ptr[u] = o; }
        }
    } else {
        const int li = l >> 1; const float* TG = (const float*)(pws(p) + OFF_TABG);
        const int l16 = tidx() & 15; const float* gq = pin(p, I_OQN); const float* gk = pin(p, I_OKN);
        constexpr int NTOT = MROWS * 2 * 16;
        for (int i0 = gt; i0 < NTOT; i0 += NU * GT) {
            bf16* ptr[NU]; v4u w[NU]; bool ok[NU]; int hh[NU], rr[NU];
#pragma unroll
            for (int u = 0; u < NU; ++u) { const int i = i0 + u * GT; ok[u] = i < NTOT; const int ii = ok[u] ? i : gt;
                const int hr = ii >> 4, r = hr >> 1; hh[u] = 8 + (hr & 1); const int b = r / SEG; rr[u] = r - b * SEG;
                ptr[u] = P + (size_t)r * ODD_IN + hh[u] * 128 + l16 * 8; w[u] = *(const v4u*)ptr[u]; }
#pragma unroll
            for (int u = 0; u < NU; ++u) { float v[8] = {bflo(w[u].x), bfhi(w[u].x), bflo(w[u].y), bfhi(w[u].y), bflo(w[u].z), bfhi(w[u].z), bflo(w[u].w), bfhi(w[u].w)};
                float ss = 0.f;
#pragma unroll
                for (int e = 0; e < 8; ++e) ss += v[e] * v[e];
                ss += __shfl_xor(ss, 1); ss += __shfl_xor(ss, 2); ss += __shfl_xor(ss, 4); ss += __shfl_xor(ss, 8);
                const float rs = rsqrtf(ss * (1.0f / 128.0f) + EPS);
                const float* g = (hh[u] < 8 ? gq : gk) + li * 128 + l16 * 8;
#pragma unroll
                for (int e = 0; e < 8; ++e) v[e] = v[e] * rs * g[e];
                if (rr[u] >= LCX) rope8(v, TG + ((size_t)(rr[u] - LCX) * 64 + l16 * 4) * 2);
                v4u o; o.x = pk2(v[0], v[1]); o.y = pk2(v[2], v[3]); o.z = pk2(v[4], v[5]); o.w = pk2(v[6], v[7]); if (ok[u]) *(v4u*)ptr[u] = o; }
        }
    }
}
#define XB_TMO      128
#define XB_XCNT(j)  (256  + 64 * (j))
#define XB_XSUB(j)  (1280 + 64 * (j))
#define XB_XGEN(j)  (2304 + 64 * (j))
#define XB_TOP      3328
#define XB_TOPGEN   3392
#define XCD_BAR_WORDS 3456
#define XB_SPIN_CAP (1u << 18)

__device__ __forceinline__ unsigned xb_ld(unsigned* p)              { return __hip_atomic_load(p, __ATOMIC_RELAXED, __HIP_MEMORY_SCOPE_AGENT); }
__device__ __forceinline__ unsigned xb_add(unsigned* p, unsigned v) { return __hip_atomic_fetch_add(p, v, __ATOMIC_RELAXED, __HIP_MEMORY_SCOPE_AGENT); }
__device__ __forceinline__ unsigned xb_xcc_id() { return (unsigned)__builtin_amdgcn_s_getreg((3 << 11) | 20) & 0xFu; }
#define XB_SPIN(cond, bar) do { unsigned _sp = 0; while (cond) { __builtin_amdgcn_s_sleep(1); \
    if ((++_sp & 255u) == 0u) { if (xb_ld(&(bar)[XB_TMO])) break; if (_sp > XB_SPIN_CAP) { atomicAdd(&(bar)[XB_TMO], 1u); break; } } } } while (0)

struct XcdBarrier {
    unsigned* bar; unsigned x;
    volatile LAS unsigned* st;
};

__device__ __forceinline__ XcdBarrier xcd_barrier_post(unsigned* bar, volatile LAS unsigned* st) {
    XcdBarrier b; b.bar = bar; b.x = xb_xcc_id(); b.st = st;
    if (threadIdx.x == 0) (void)xb_add(&bar[XB_XCNT(b.x)], 1u);
    return b;
}
__device__ __forceinline__ void xcd_barrier_complete(unsigned* bar, unsigned x, unsigned& nloc, unsigned& nx) {
    const unsigned G = gridDim.x * gridDim.y * gridDim.z;
    unsigned sum, cnt, mine, sp = 0u;
    for (;;) {
        sum = 0u; cnt = 0u; mine = 0u;
#pragma unroll
        for (unsigned j = 0; j < 16; ++j) { const unsigned c = xb_ld(&bar[XB_XCNT(j)]); sum += c; cnt += (c > 0u) ? 1u : 0u; mine = (j == x) ? c : mine; }
        if (sum == G) break;
        __builtin_amdgcn_s_sleep(1);
        if ((++sp & 255u) == 0u) { if (xb_ld(&bar[XB_TMO])) break; if (sp > XB_SPIN_CAP) { atomicAdd(&bar[XB_TMO], 1u); break; } }
    }
    nloc = mine > 0u ? mine : 1u; nx = cnt > 0u ? cnt : 1u;
}

__device__ __forceinline__ void xcd_barrier(const XcdBarrier& b) {
    asm volatile("s_waitcnt vmcnt(0)" ::: "memory");
    __syncthreads();
    if (threadIdx.x == 0) {
        unsigned* bar = b.bar;
        __builtin_amdgcn_s_waitcnt(0);
        unsigned nloc = b.st[0], nx = b.st[1];
        if (nloc == 0u) { xcd_barrier_complete(bar, b.x, nloc, nx); b.st[0] = nloc; b.st[1] = nx; }
        const unsigned old = xb_add(&bar[XB_XSUB(b.x)], 1u);
        const unsigned gen = old / nloc;
        if (old + 1u == (gen + 1u) * nloc) {
            __builtin_amdgcn_fence(__ATOMIC_RELEASE, "agent");
            asm volatile("s_waitcnt vmcnt(0)" ::: "memory");
            const unsigned og = xb_add(&bar[XB_TOP], 1u);
            const unsigned tg = og / nx;
            if (og + 1u == (tg + 1u) * nx) xb_add(&bar[XB_TOPGEN], 1u);
            else XB_SPIN(xb_ld(&bar[XB_TOPGEN]) == tg, bar);
            __builtin_amdgcn_fence(__ATOMIC_ACQUIRE, "agent");
            xb_add(&bar[XB_XGEN(b.x)], 1u);
            asm volatile("s_waitcnt vmcnt(0)" ::: "memory");
        } else {
            XB_SPIN(xb_ld(&bar[XB_XGEN(b.x)]) == gen, bar);
            __builtin_amdgcn_fence(__ATOMIC_ACQUIRE, "agent");
            asm volatile("s_waitcnt vmcnt(0)" ::: "memory");
        }
    }
    __syncthreads();
}
__device__ __forceinline__ float fast_sigmoid(float x) { return __builtin_amdgcn_rcpf(1.0f + __builtin_amdgcn_exp2f(-1.4426950408889634f * x)); }
__device__ __forceinline__ float gelu_tanh(float x) { const float u = 0.7978845608028654f * (x + 0.044715f * x * x * x); const float th = 1.0f - 2.0f * __builtin_amdgcn_rcpf(1.0f + __builtin_amdgcn_exp2f(2.8853900817779268f * u)); return 0.5f * x * (1.0f + th); }
template <bool FINAL>
__device__ __forceinline__ void phase_lru(const Params& p, int l, char* lds) {
    typedef float f32x4_ __attribute__((ext_vector_type(4)));
    const int tid = tidx(), wid = tid >> 6, lane = tid & 63, li = l >> 1, bx = bidx(), G_ = (int)gridDim.x;
    float* xs = (float*)lds;
    float* xcf = (float*)(lds + 17408);
    bf16* xcb = (bf16*)(lds + 17408 + 16384);
    bf16* lw = (bf16*)(lds + 17408 + 16384 + 9216);
    float* G = (float*)(lds + 17408 + 16384 + 9216 + 36864);
    float* SEGA = (float*)(lds + 145408);
    float* SEGB = SEGA + 512;
    const bf16* P = (const bf16*)(pws(p) + OFF_P); bf16* Z = (bf16*)(pws(p) + OFF_Z);
    float* CHA = (float*)(pws(p) + OFF_CHA); float* CHB = (float*)(pws(p) + OFF_CHB); const float* CAR = (const float*)(pws(p) + OFF_CAR);
    const bool fixed_h = (G_ & 7) == 0; int h_loaded = -1;
    float cw0 = 0.f, cw1 = 0.f, cw2 = 0.f, cw3 = 0.f, cwb = 0.f, kba[2] = {0.f, 0.f}, kbx[2] = {0.f, 0.f}, ksp[2] = {0.f, 0.f};
    v4u pre0 = (v4u){0u, 0u, 0u, 0u}, pre1 = (v4u){0u, 0u, 0u, 0u};
#define LRU_HALO_LOAD(TILE) do { const int h_ = (TILE) & 7, ck_ = ((TILE) >> 3) % NCHUNK, b_ = ((TILE) >> 3) / NCHUNK, lo_ = ck_ < 4 ? 0 : LCX, hi_ = ck_ < 4 ? LCX : SEG; \
        { const int hr = tid >> 3, c8 = (tid & 7) * 8, rr = ck_ * 64 - 2 + hr; pre0 = (rr >= lo_ && rr < hi_) ? *(const v4u*)(P + ((size_t)b_ * SEG + rr) * EVEN_IN + h_ * 64 + c8) : (v4u){0u, 0u, 0u, 0u}; } \
        if (tid < 24) { const int hr = 64 + (tid >> 3), c8 = (tid & 7) * 8, rr = ck_ * 64 - 2 + hr; pre1 = (rr >= lo_ && rr < hi_) ? *(const v4u*)(P + ((size_t)b_ * SEG + rr) * EVEN_IN + h_ * 64 + c8) : (v4u){0u, 0u, 0u, 0u}; } } while (0)
#define LRU_HALO_PUT(W, C) do { const int hr = (C) >> 3, c8 = ((C) & 7) * 8; \
        *(f32x4_*)(xs + hr * 64 + c8) = (f32x4_){bflo((W).x), bfhi((W).x), bflo((W).y), bfhi((W).y)}; *(f32x4_*)(xs + hr * 64 + c8 + 4) = (f32x4_){bflo((W).z), bfhi((W).z), bflo((W).w), bfhi((W).w)}; } while (0)
    if (bx < NB * NCHUNK * 8) LRU_HALO_LOAD(bx);
    for (int tile = bx; tile < NB * NCHUNK * 8; tile += G_) {
        const int h = tile & 7, ck = (tile >> 3) % NCHUNK, b = (tile >> 3) / NCHUNK;
        const int seg_lo = ck < 4 ? 0 : LCX, seg_hi = ck < 4 ? LCX : SEG, t0 = ck * 64;
        const size_t rbase = (size_t)b * SEG;
        LRU_HALO_PUT(pre0, tid); if (tid < 24) LRU_HALO_PUT(pre1, tid + 512);
        v4u gaw = (v4u){0u, 0u, 0u, 0u}; float carry_in = 0.f;
        if (FINAL) { gaw = *(const v4u*)(P + (rbase + t0 + (tid >> 3)) * EVEN_IN + LRUW + h * 64 + (tid & 7) * 8);
            if (tid < 128) carry_in = CAR[(((size_t)(tid >> 6) * NB + b) * NCHUNK + ck) * LRUW + h * 64 + (tid & 63)]; }
        if (!fixed_h || h_loaded != h) { const bf16* LW = (const bf16*)(pws(p) + OFF_LW) + (size_t)h * 256 * 64; h_loaded = h;
          { const int ch = tid & 63; const float* cw = pin(p, I_ECW) + (size_t)li * 4 * LRUW + h * 64 + ch; cw0 = cw[0]; cw1 = cw[LRUW]; cw2 = cw[2 * LRUW]; cw3 = cw[3 * LRUW]; cwb = pin(p, I_ECB)[li * LRUW + h * 64 + ch];
#pragma unroll
            for (int dir = 0; dir < 2; ++dir) { const int cidx = (li * 2 + dir) * LRUW + h * 64 + ch; kba[dir] = pin(p, I_LBA)[cidx]; kbx[dir] = pin(p, I_LBX)[cidx]; ksp[dir] = -8.0f * log1pf(expf(-pin(p, I_LAM)[cidx])); } }
#pragma unroll
          for (int q = 0; q < 4; ++q) { const int c = tid + q * NTHR, n = c >> 3, c8 = (c & 7) * 8; *(v4u*)(lw + n * 72 + c8) = *(const v4u*)(LW + n * 64 + c8); } }
        __syncthreads();
        { const int ch = tid & 63, tb = (tid >> 6) * 8; float xv[11], cv[8];
#pragma unroll
          for (int i = 0; i < 11; ++i) xv[i] = xs[(tb + i) * 64 + ch];
#pragma unroll
          for (int i = 0; i < 8; ++i) cv[i] = cwb + cw0 * xv[i] + cw1 * xv[i + 1] + cw2 * xv[i + 2] + cw3 * xv[i + 3];
#pragma unroll
          for (int i = 0; i < 8; ++i) { xcf[(tb + i) * 64 + ch] = cv[i]; xcb[(tb + i) * 72 + ch] = (bf16)f2bf(cv[i]); } }
        __syncthreads();
        if (tile + G_ < NB * NCHUNK * 8) LRU_HALO_LOAD(tile + G_);
        { const int fr = lane & 15, fq = lane >> 4;
          f32x4_ acc[4][2];
#pragma unroll
          for (int m = 0; m < 4; ++m)
#pragma unroll
              for (int n = 0; n < 2; ++n) acc[m][n] = (f32x4_){0.f, 0.f, 0.f, 0.f};
#pragma unroll
          for (int k = 0; k < 2; ++k) { bf16x8 af[4], bfr[2];
#pragma unroll
              for (int m = 0; m < 4; ++m) af[m] = *(const bf16x8*)(xcb + (m * 16 + fr) * 72 + k * 32 + fq * 8);
#pragma unroll
              for (int n = 0; n < 2; ++n) bfr[n] = *(const bf16x8*)(lw + (wid * 32 + n * 16 + fr) * 72 + k * 32 + fq * 8);
#pragma unroll
              for (int m = 0; m < 4; ++m)
#pragma unroll
                  for (int n = 0; n < 2; ++n) acc[m][n] = __builtin_amdgcn_mfma_f32_16x16x32_bf16(af[m], bfr[n], acc[m][n], 0, 0, 0); }
#pragma unroll
          for (int m = 0; m < 4; ++m)
#pragma unroll
              for (int n = 0; n < 2; ++n) { const int ncol = wid * 32 + n * 16 + fr, g = ncol >> 6, j = ncol & 63;
#pragma unroll
                  for (int e = 0; e < 4; ++e) G[(g * 64 + m * 16 + fq * 4 + e) * 64 + j] = acc[m][n][e]; } }
        __syncthreads();
        { const int ch = tid & 63, tb = (tid >> 6) * 8; float xc8[8];
#pragma unroll
          for (int i = 0; i < 8; ++i) xc8[i] = xcf[(tb + i) * 64 + ch];
#pragma unroll
          for (int dir = 0; dir < 2; ++dir) { const float ba = kba[dir], bxx = kbx[dir], sp8 = ksp[dir]; float gav[8], gxv[8];
              float* ga = G + ((2 * dir) * 64 + tb) * 64 + ch; float* gx = G + ((2 * dir + 1) * 64 + tb) * 64 + ch;
#pragma unroll
              for (int i = 0; i < 8; ++i) { gav[i] = ga[i * 64]; gxv[i] = gx[i * 64]; }
#pragma unroll
              for (int i = 0; i < 8; ++i) {
                  const float ea = __builtin_amdgcn_exp2f(fminf(-1.4426950408889634f * (gav[i] + ba), 60.0f)), eb = __builtin_amdgcn_exp2f(fminf(-1.4426950408889634f * (gxv[i] + bxx), 60.0f));
                  const float A1 = 1.0f + ea, B1 = 1.0f + eb, rab = __builtin_amdgcn_rcpf(A1 * B1), r = B1 * rab, ig = A1 * rab, la = r * sp8, z = 2.0f * la;
                  float av = 1.0f + la * (1.0f + la * (0.5f + la * (0.16666667f + la * (0.041666668f + la * 0.0083333338f))));
                  float om = -z * (1.0f + z * (0.5f + z * (0.16666667f + z * (0.041666668f + z * (0.0083333338f + z * 0.0013888889f)))));
                  if (__builtin_expect(__any(la < -0.25f), 0)) { if (la < -0.25f) { av = __builtin_amdgcn_exp2f(1.4426950408889634f * la); om = 1.0f - __builtin_amdgcn_exp2f(1.4426950408889634f * z); } }
                  gav[i] = av; gxv[i] = __builtin_amdgcn_sqrtf(om) * ig * xc8[i]; }
#pragma unroll
              for (int i = 0; i < 8; ++i) { ga[i * 64] = gav[i]; gx[i * 64] = gxv[i]; } } }
        __syncthreads();
        { const int sg = tid >> 7, dc = tid & 127, dir = dc >> 6, ch = dc & 63;
          float* ga = G + (2 * dir) * 4096 + ch; float* gb = G + (2 * dir + 1) * 4096 + ch;
          float hs = 0.f, ap = 1.f, av[16], bv[16];
          const int tq0 = dir ? 63 - sg * 16 : sg * 16, tst = dir ? -64 : 64;
          float* gaq = ga + tq0 * 64; float* gbq = gb + tq0 * 64;
#pragma unroll
          for (int i = 0; i < 16; ++i) { av[i] = gaq[i * tst]; bv[i] = gbq[i * tst]; }
#pragma unroll
          for (int i = 0; i < 16; ++i) { hs = av[i] * hs + bv[i]; ap *= av[i]; av[i] = ap; bv[i] = hs; }
          if (FINAL) {
#pragma unroll
              for (int i = 0; i < 16; ++i) { gaq[i * tst] = av[i]; gbq[i * tst] = bv[i]; } }
          SEGA[sg * 128 + dc] = ap; SEGB[sg * 128 + dc] = hs; }
        __syncthreads();
        if (tid < 128) { const int dir = tid >> 6, ch = tid & 63; const size_t sidx = (((size_t)dir * NB + b) * NCHUNK + ck) * LRUW + h * 64 + ch;
            float hin = carry_in, apt = 1.f;
#pragma unroll
            for (int sg = 0; sg < 4; ++sg) { const float a = SEGA[sg * 128 + tid], bb = SEGB[sg * 128 + tid]; if (FINAL) SEGA[sg * 128 + tid] = hin; hin = a * hin + bb; apt *= a; }
            if (!FINAL) { CHA[sidx] = apt; CHB[sidx] = hin; } }
        if (FINAL) { __syncthreads();
            { const int t = tid >> 3, c8 = (tid & 7) * 8; const size_t row = rbase + t0 + t;
              const v4u w = gaw;
              const float gv[8] = {bflo(w.x), bfhi(w.x), bflo(w.y), bfhi(w.y), bflo(w.z), bfhi(w.z), bflo(w.w), bfhi(w.w)};
              const int sf = t >> 4, sb = (63 - t) >> 4;
              float o[8];
#pragma unroll
              for (int e = 0; e < 8; ++e) { const int c = c8 + e;
                  const float hf = G[(64 + t) * 64 + c] + G[t * 64 + c] * SEGA[sf * 128 + c], hb = G[(192 + t) * 64 + c] + G[(128 + t) * 64 + c] * SEGA[sb * 128 + 64 + c];
                  o[e] = (hf + hb) * gelu_tanh(gv[e]); }
              v4u ov; ov.x = pk2(o[0], o[1]); ov.y = pk2(o[2], o[3]); ov.z = pk2(o[4], o[5]); ov.w = pk2(o[6], o[7]);
              *(v4u*)(Z + row * DM + h * 64 + c8) = ov; } }
        __syncthreads();
    }
#undef LRU_HALO_LOAD
#undef LRU_HALO_PUT
}
__device__ __forceinline__ void phase_lru_carry(const Params& p) {
    const float* CHA = (const float*)(pws(p) + OFF_CHA); const float* CHB = (const float*)(pws(p) + OFF_CHB); float* CAR = (float*)(pws(p) + OFF_CAR);
    const int nb = 2 * NB * LRUW / NTHR, first = (int)gridDim.x >= nb ? (int)gridDim.x - nb : 0;
    const int bx = bidx(); if (bx < first) return;
    for (int g = (bx - first) * NTHR + tidx(); g < 2 * NB * LRUW; g += ((int)gridDim.x - first) * NTHR) {
        const int c = g % LRUW, b = (g / LRUW) % NB, dir = g / (LRUW * NB);
        const size_t base = ((size_t)dir * NB + b) * NCHUNK * LRUW + c;
        float hs = 0.f;
        for (int s0 = 0; s0 < NCHUNK; s0 += 22) {
            float av[22], bv[22]; int ck[22];
#pragma unroll
            for (int j = 0; j < 22; ++j) { const int s = s0 + j; ck[j] = dir == 0 ? s : (s < 4 ? 3 - s : NCHUNK - 1 - (s - 4)); av[j] = CHA[base + (size_t)ck[j] * LRUW]; bv[j] = CHB[base + (size_t)ck[j] * LRUW]; }
#pragma unroll
            for (int j = 0; j < 22; ++j) { CAR[base + (size_t)ck[j] * LRUW] = hs; hs = av[j] * hs + bv[j]; }
        }
    }
}

__device__ __forceinline__ void phase_attn(const Params& p, int l, char* lds) {
    const bf16* P = (const bf16*)(pws(p) + OFF_P); bf16* Z = (bf16*)(pws(p) + OFF_Z);
    const bool even = (l & 1) == 0, with_ctx = l < DEPTH - 1; const int li = l >> 1;
    const int nunits = 1024 + (with_ctx ? 32 : 0);
    for (int idx = bidx(); idx < nunits; idx += gridDim.x) {
        if (idx < 1024) {
            const int g = idx & 7, local = idx >> 3, b = g >> 1, kv = g & 1, h = kv * 4 + (local >> 5), qb = local & 31, q0 = qb * 256;
            const size_t kbase = (size_t)b * SEG, qrow = kbase + LCX + q0;
            if (even) {
                const int pair = local >> 6, qb2 = local & 63, q0w = qb2 * 128, h0 = kv * 4 + pair * 2; const size_t qrow2 = kbase + LCX + q0w;
                const int band0 = q0w - 128 < 0 ? 0 : q0w - 128, bend = q0w + 256 > SEQ ? SEQ : q0w + 256, NT = 4 + (bend - band0) / 64;
                att::attn_body<64, EVEN_IN, EVEN_IN, DM, 128, true, 1, 128>(P + qrow2 * EVEN_IN + 1024 + h0 * 64, P + kbase * EVEN_IN + 1536 + kv * 64,
                    Z + qrow2 * DM + 512 + h0 * 64, NT, band0, q0w, pin(p, I_SINK)[li * 8 + h0] * 1.4426950408889634f, nullptr, (const float*)(pws(p) + OFF_TABW) + (size_t)q0w * 64, lds, pin(p, I_SINK)[li * 8 + h0 + 1] * 1.4426950408889634f);
            } else {
                att::attn_body<128, ODD_IN, ODD_IN, DM, 256, false, 3>(P + qrow * ODD_IN + h * 128, P + kbase * ODD_IN + 1024 + kv * 128,
                    Z + qrow * DM + h * 128, SEG / 64, 0, q0, -INFINITY, pin(p, I_OQN) + li * 128, (const float*)(pws(p) + OFF_TABG) + (size_t)q0 * 128, lds);
            }
        } else {
            const int u = idx - 1024, b = u >> 3, h = u & 7, kv = h >> 2; const size_t kbase = (size_t)b * SEG;
            if (even) att::attn_body<64, EVEN_IN, EVEN_IN, DM, 128, false, 0>(P + kbase * EVEN_IN + 1024 + h * 64, P + kbase * EVEN_IN + 1536 + kv * 64,
                    Z + kbase * DM + 512 + h * 64, 4, 0, 0, pin(p, I_SINK)[li * 8 + h] * 1.4426950408889634f, nullptr, nullptr, lds);
            else att::attn_body<128, ODD_IN, ODD_IN, DM, 256, false, 2>(P + kbase * ODD_IN + h * 128, P + kbase * ODD_IN + 1024 + kv * 128,
                    Z + kbase * DM + h * 128, 4, 0, 0, -INFINITY, pin(p, I_OQN) + li * 128, nullptr, lds);
        }
    }
}

constexpr int PPL = 15, NPHASE = 1 + DEPTH * PPL;
constexpr int MISC_OFF = LDS_BYTES - 64;
__device__ __forceinline__ bool phase_exists(int ph) {
    if (ph == 0) return true; const int l = (ph - 1) / PPL, k = (ph - 1) % PPL;
    if (k == 8 && (l & 1)) return false; if (k == 11 && l == DEPTH - 1) return false; return true;
}
__global__ void __launch_bounds__(NTHR, 2) fwd_kernel(Params p) {
    extern __shared__ __attribute__((aligned(16))) unsigned char lds_raw[];
    char* lds = (char*)lds_raw; LAS unsigned char* ldsl = (LAS unsigned char*)lds_raw;
    volatile LAS unsigned* MISC = (volatile LAS unsigned*)(ldsl + MISC_OFF);
    cg::grid_group grid = cg::this_grid();
    if (threadIdx.x < 16) MISC[threadIdx.x] = 0u;
    __syncthreads();
    XcdBarrier bar = xcd_barrier_post((unsigned*)(p.ws + OFF_CTL) + CW_BAR, MISC);
    for (int ph = p.lo, rep = 0; ph < p.hi;) {
        int nrep = 1;
        asm volatile("" : "+s"(ph));
        const bool did = phase_exists(ph);
        if (ph == 0) { for (int r_ = 0; r_ < p.rep_misc; ++r_) phase_mod(p, lds); __syncthreads(); phase_convert(p, 0, ldsl); }
        else if (did) {
            const int l = (ph - 1) / PPL, k = (ph - 1) % PPL; const bool even = (l & 1) == 0, lastl = l == DEPTH - 1;
            nrep = (k == 1 || k == 2 || k == 5 || k == 9 || k == 12 || k == 13) ? p.rep_gemm : (k == 7 ? p.rep_att : 1);
            bf16* U = (bf16*)(pws(p) + OFF_U); bf16* A = (bf16*)(pws(p) + OFF_A); bf16* Pb = (bf16*)(pws(p) + OFF_P); bf16* Z = (bf16*)(pws(p) + OFF_Z); bf16* Y = (bf16*)(pws(p) + OFF_Y);
            const int G = (int)gridDim.x;
            switch (k) {
            case 0: if (l != 0) for (int r_ = 0; r_ < p.rep_misc; ++r_) { phase_convert(p, l, ldsl); __syncthreads(); } phase_rowpass(p, l, 0, l == 0 ? 0 : 2, 0, CTX_KSPLIT && l != 0); break;
            case 1: case 12: { pg8::Gemm g{U, (const bf16*)(pws(p) + (k == 1 ? OFF_WGU0 : OFF_WGU1)), MROWS, NGU, DM}; pg8::OrderX S; S.init(MROWS, NGU, G, bidx(), lastl && k == 12);
                pg8::EpiSwiglu E{A, FF}; pg8::gemm_phase<pg8::EpiSwiglu, pg8::OrderX, true, true>(ldsl, g, S, E); } break;
            case 2: case 9: case 13: { pg8::Gemm g{k == 9 ? Z : A, (const bf16*)(pws(p) + (k == 2 ? OFF_WD0 : (k == 9 ? OFF_WOUT : OFF_WD1))), MROWS, DM, k == 9 ? DM : FF}; pg8::OrderX S; S.init(MROWS, DM, G, bidx(), true);
                pg8::EpiBf16 E{Y, DM}; pg8::gemm_phase<pg8::EpiBf16, pg8::OrderX, true, true>(ldsl, g, S, E); } break;
            case 3: case 10: case 14: { const bool ctx = !(lastl && k != 3);
                int ncu = 0;
                if (ctx && (k == 10 || !CTX_KSPLIT)) { ncu = 16; pg8::Gemm g{k == 10 ? Z : A, (const bf16*)(pws(p) + (k == 3 ? OFF_WD0 : (k == 10 ? OFF_WOUT : OFF_WD1))), MROWS, DM, k == 10 ? DM : FF, 0}; pg8::OrderCtx S{bidx()};
                    pg8::EpiBf16 E{Y, DM}; pg8::gemm_phase<pg8::EpiBf16, pg8::OrderCtx, true, true>(ldsl, g, S, E); }
                else if (ctx) { ncu = 32; const int c = bidx(), kh = c & 1, j = (c >> 3) & 3;
                    pg8::Gemm g{A + (size_t)32 * j * 256 * FF + kh * (FF / 2), (const bf16*)(pws(p) + (k == 3 ? OFF_WD0 : OFF_WD1)) + kh * (FF / 2), NB * LCX, DM, FF / 2, FF}; pg8::OrderCtx2 S{c};
                    pg8::EpiF32 E{(float*)(pws(p) + OFF_PB) + (size_t)kh * NB * LCX * DM, DM}; pg8::gemm_phase<pg8::EpiF32, pg8::OrderCtx2, true, true>(ldsl, g, S, E); }
                phase_rowpass(p, k == 14 ? l + 1 : l, k == 3 ? 1 : (k == 10 ? 2 : 0), 1, G > ncu ? ncu : 0, false, ncu == 32 ? CTX_SHARE32 : (ncu == 16 ? CTX_SHARE16 : 0)); } break;
            case 4: phase_rowpass(p, l, 1, 2, 0, CTX_KSPLIT != 0); break;
            case 11: phase_rowpass(p, l, 2, 2, 0); break;
            case 5: { const int nin = even ? EVEN_IN : ODD_IN; pg8::Gemm g{U, (const bf16*)(pws(p) + OFF_WIN), MROWS, nin, DM}; pg8::OrderX S; S.init(MROWS, nin, G, bidx(), false);
                pg8::EpiBf16 E{Pb, nin}; pg8::gemm_phase<pg8::EpiBf16, pg8::OrderX, true, true>(ldsl, g, S, E); } break;
            case 6: if (even) for (int r_ = 0; r_ < p.rep_lru; ++r_) phase_lru<false>(p, l, lds); phase_prep(p, l); break;
            case 7: if (even) phase_lru_carry(p); phase_attn(p, l, lds); break;
            case 8: for (int r_ = 0; r_ < p.rep_lru; ++r_) phase_lru<true>(p, l, lds); break;
            default: break;
            }
        }
        bool more = rep + 1 < nrep;
        for (int q = ph + 1; !more && q < p.hi; ++q) more = phase_exists(q);
        if (did && more) { if (p.hi < 0) grid.sync(); else for (int r_ = 0; r_ < p.rep_bar; ++r_) xcd_barrier(bar); }
        if (rep + 1 < nrep) ++rep; else { rep = 0; ++ph; }
    }
}

extern "C" void kernel_launch(void* const* d_in, const int* in_sizes, int n_in, void* d_out, int out_size, void* d_ws, size_t ws_size, hipStream_t stream) {
    static int grid = 0;
    if (grid == 0) {
        if (n_in != 25 || out_size != NB * SEQ * DM || ws_size < WS_NEED) { fprintf(stderr, "kernel_launch: unexpected shapes (n_in %d out %d ws %zu, need ws >= %zu)\n", n_in, out_size, ws_size, (size_t)WS_NEED); grid = -1; return; }
        int dev = 0, cus = 0, per_cu = 0;
        hipGetDevice(&dev); hipDeviceGetAttribute(&cus, hipDeviceAttributeMultiprocessorCount, dev);
        if (hipFuncSetAttribute((const void*)fwd_kernel, hipFuncAttributeMaxDynamicSharedMemorySize, LDS_BYTES) != hipSuccess) { fprintf(stderr, "kernel_launch: hipFuncSetAttribute failed\n"); grid = -1; return; }
        if (hipOccupancyMaxActiveBlocksPerMultiprocessor(&per_cu, (const void*)fwd_kernel, NTHR, LDS_BYTES) != hipSuccess || per_cu < 1) { fprintf(stderr, "kernel_launch: occupancy query says %d\n", per_cu); per_cu = 1; }
        (void)hipGetLastError();
        grid = cus * per_cu;
        fprintf(stderr, "kernel_launch: grid %d (cus %d x %d)\n", grid, cus, per_cu);
    }
    if (grid < 0) return;
    if (hipMemsetAsync((char*)d_ws + OFF_CTL, 0, CTL_BYTES, stream) != hipSuccess) { fprintf(stderr, "kernel_launch: memset of the control words failed\n"); return; }
    Params p{};
    for (int i = 0; i < 25; ++i) p.in[i] = (const float*)d_in[i];
    p.out = (float*)d_out; p.ws = (unsigned char*)d_ws; p.rep_gemm = REP_GEMM; p.rep_att = REP_ATT; p.rep_lru = REP_LRU; p.rep_misc = REP_MISC; p.rep_bar = REP_BAR;
#if MK_SINGLE
    p.lo = 0; p.hi = NPHASE;
    void* args[] = {&p};
    hipError_t e = hipLaunchCooperativeKernel((const void*)fwd_kernel, dim3(grid), dim3(NTHR), args, LDS_BYTES, stream);
    if (e != hipSuccess) fprintf(stderr, "cooperative launch failed: %s (grid %d)\n", hipGetErrorString(e), grid);
#else
    for (int ph = 0; ph < NPHASE; ++ph) {
        if (ph >= 1) { const int k = (ph - 1) % PPL, l = (ph - 1) / PPL; if ((k == 8 && (l & 1)) || (k == 11 && l == DEPTH - 1)) continue; }
        p.lo = ph; p.hi = ph + 1;
        hipLaunchKernelGGL(fwd_kernel, dim3(grid), dim3(NTHR), LDS_BYTES, stream, p);
    }
#endif
}
```
